# Optimizing an MI355X kernel written in HIP

```python
import math
import jax, jax.numpy as jnp
from jax import lax
import numpy as np

D_MODEL = 1024
BATCH = 8
SEQ = 2048
DEPTH = 1

PLE_DIM = 256
D_MIX = D_MODEL
D_LRU = D_MIX // 2
LRU_BLOCKS = 8
LRU_BLOCK_DIM = D_LRU // LRU_BLOCKS
CONV_WIDTH = 4
LRU_C = 8.0
D_ATTN = D_MIX - D_LRU
N_ATT_HEADS = 8
HEAD_DIM = D_ATTN // N_ATT_HEADS
DILATED_GROUPS = ((128, 1), (512, 4), (2048, 16))
ATT_BLOCK = 128
REL_BUCKETS = 32
REL_MAX_DIST = 2048
PEER_HEADS = 8
PEER_NKEYS = 128
PEER_EXPERTS = PEER_NKEYS * PEER_NKEYS
PEER_QDIM = 256
PEER_TOPK = 16
PEER_TOKEN_BLOCK = 128
NORM_EPS = 1e-6
D_IN_PROJ = 2 * D_LRU + 3 * D_ATTN

kernel_name = 'hybrid_rglru_dilated_attn_peer'


def rmsnorm(x, g):
    xf = x.astype(jnp.float32)
    y = xf * lax.rsqrt(jnp.mean(xf * xf, axis=-1, keepdims=True) + NORM_EPS)
    return (y * g.astype(jnp.float32)).astype(x.dtype)


def t5_causal_bucket(dist):
    max_exact = REL_BUCKETS // 2
    n = jnp.maximum(dist, 0)
    nf = jnp.maximum(n, 1).astype(jnp.float32)
    large = max_exact + (jnp.log(nf / max_exact) / math.log(REL_MAX_DIST / max_exact)
                         * (REL_BUCKETS - max_exact)).astype(jnp.int32)
    large = jnp.minimum(large, REL_BUCKETS - 1)
    return jnp.where(n < max_exact, n, large)


def causal_depthwise_conv(x, w, b):
    y = lax.conv_general_dilated(
        x, w[:, None, :], window_strides=(1,), padding=[(CONV_WIDTH - 1, 0)],
        dimension_numbers=('NWC', 'WIO', 'NWC'), feature_group_count=x.shape[-1])
    return y + b


def rg_lru(x, w_rg, b_rg, w_ig, b_ig, lam):
    B, T, C = x.shape
    xf = x.astype(jnp.float32)
    xb = xf.reshape(B, T, LRU_BLOCKS, LRU_BLOCK_DIM)
    r = jax.nn.sigmoid(jnp.einsum('btgi,gij->btgj', xb, w_rg.astype(jnp.float32)).reshape(B, T, C)
                       + b_rg.astype(jnp.float32))
    i = jax.nn.sigmoid(jnp.einsum('btgi,gij->btgj', xb, w_ig.astype(jnp.float32)).reshape(B, T, C)
                       + b_ig.astype(jnp.float32))
    log_a = -LRU_C * r * jax.nn.softplus(-lam.astype(jnp.float32))
    a = jnp.exp(log_a)
    bterm = jnp.sqrt(-jnp.expm1(2.0 * log_a)) * (i * xf)

    def combine(c1, c2):
        a1, b1 = c1
        a2, b2 = c2
        return a1 * a2, a2 * b1 + b2

    _, h = lax.associative_scan(combine, (a, bterm), axis=1)
    return h.astype(x.dtype)


def dilated_branch(q, k, v, rel_bias, window, dilation):
    B, T, H, Dh = q.shape
    L = T // dilation
    W = window // dilation
    nb = -(-L // ATT_BLOCK)
    Lp = nb * ATT_BLOCK
    n_prev = -(-W // ATT_BLOCK)
    band = (n_prev + 1) * ATT_BLOCK

    def to_sub(t):
        return t.reshape(B, L, dilation, H, Dh).transpose(0, 2, 3, 1, 4)

    qs = jnp.pad(to_sub(q), ((0, 0), (0, 0), (0, 0), (0, Lp - L), (0, 0)))
    qb = qs.reshape(B, dilation, H, nb, ATT_BLOCK, Dh)
    pad_kv = ((0, 0), (0, 0), (0, 0), (n_prev * ATT_BLOCK, Lp - L), (0, 0))

    def bands(t):
        tb = jnp.pad(to_sub(t), pad_kv).reshape(B, dilation, H, nb + n_prev, ATT_BLOCK, Dh)
        return jnp.concatenate([tb[:, :, :, j:j + nb] for j in range(n_prev + 1)], axis=4)

    kb = bands(k)
    vb = bands(v)
    qi = jnp.arange(ATT_BLOCK)[:, None]
    kj = jnp.arange(band)[None, :]
    dist_sub = qi + n_prev * ATT_BLOCK - kj
    key_sub = (jnp.arange(nb)[:, None, None] - n_prev) * ATT_BLOCK + kj[None]
    mask = (dist_sub >= 0) & (dist_sub <= W) & (key_sub >= 0)
    bias = rel_bias[t5_causal_bucket(dist_sub * dilation)].transpose(2, 0, 1)

    s = jnp.einsum('bdhnqc,bdhnkc->bdhnqk', qb, kb) + bias[None, None, :, None].astype(jnp.float32)
    s = jnp.where(mask[None, None, None], s, -jnp.inf)
    m = jnp.max(s, axis=-1, keepdims=True)
    e = jnp.exp(s - m)
    den = jnp.sum(e, axis=-1)
    o = jnp.einsum('bdhnqk,bdhnkc->bdhnqc', e, vb) / den[..., None]
    lse = m[..., 0] + jnp.log(den)
    o = o.reshape(B, dilation, H, Lp, Dh)[:, :, :, :L].transpose(0, 3, 1, 2, 4).reshape(B, T, H, Dh)
    lse = lse.reshape(B, dilation, H, Lp)[..., :L].transpose(0, 3, 1, 2).reshape(B, T, H)
    return o, lse


def dilated_attention(q, k, v, rel_bias):
    outs = []
    lses = []
    for window, dilation in DILATED_GROUPS:
        o, lse = dilated_branch(q, k, v, rel_bias, window, dilation)
        outs.append(o)
        lses.append(lse)
    wts = jax.nn.softmax(jnp.stack(lses, axis=0), axis=0)
    return jnp.sum(wts[..., None] * jnp.stack(outs, axis=0), axis=0)


def hybrid_mixer(u, w_in, conv_w, conv_b, w_rg, b_rg, w_ig, b_ig, lru_lambda,
                 g_lru_out, g_attn_out, w_out, rel_bias):
    B, T, _ = u.shape
    z = u @ w_in
    x_lru = z[..., :D_LRU]
    gate = z[..., D_LRU:2 * D_LRU]
    o0 = 2 * D_LRU
    q = z[..., o0:o0 + D_ATTN]
    k = z[..., o0 + D_ATTN:o0 + 2 * D_ATTN]
    v = z[..., o0 + 2 * D_ATTN:]
    xc = causal_depthwise_conv(x_lru, conv_w, conv_b)
    y_lru = rg_lru(xc, w_rg, b_rg, w_ig, b_ig, lru_lambda) * jax.nn.gelu(gate)
    qh = q.reshape(B, T, N_ATT_HEADS, HEAD_DIM).astype(jnp.float32) * (HEAD_DIM ** -0.5)
    kh = k.reshape(B, T, N_ATT_HEADS, HEAD_DIM).astype(jnp.float32)
    vh = v.reshape(B, T, N_ATT_HEADS, HEAD_DIM).astype(jnp.float32)
    y_att = dilated_attention(qh, kh, vh, rel_bias).reshape(B, T, D_ATTN).astype(u.dtype)
    y = jnp.concatenate([rmsnorm(y_lru, g_lru_out), rmsnorm(y_att, g_attn_out)], axis=-1)
    return y @ w_out


def peer_ffn(x, w_pq, peer_k1, peer_k2, peer_u, peer_v):
    B, T, D = x.shape
    N = B * T
    xt = x.reshape(N, D)
    half = PEER_QDIM // 2
    q = (xt @ w_pq).astype(jnp.float32).reshape(N, PEER_HEADS, PEER_QDIM)
    s1 = jnp.einsum('nhc,kc->nhk', q[..., :half], peer_k1.astype(jnp.float32))
    s2 = jnp.einsum('nhc,kc->nhk', q[..., half:], peer_k2.astype(jnp.float32))
    t1, i1 = lax.top_k(s1, PEER_TOPK)
    t2, i2 = lax.top_k(s2, PEER_TOPK)
    cand_s = (t1[..., :, None] + t2[..., None, :]).reshape(N, PEER_HEADS, PEER_TOPK * PEER_TOPK)
    cand_id = (i1[..., :, None] * PEER_NKEYS + i2[..., None, :]).reshape(N, PEER_HEADS, PEER_TOPK * PEER_TOPK)
    top_s, top_pos = lax.top_k(cand_s, PEER_TOPK)
    ids = jnp.take_along_axis(cand_id, top_pos, axis=-1)
    g = jax.nn.softmax(top_s, axis=-1).astype(x.dtype)
    nblk = N // PEER_TOKEN_BLOCK

    def expert_block(args):
        xb, idb, gb = args
        act = jax.nn.gelu(jnp.einsum('td,thkd->thk', xb, peer_u[idb])) * gb
        return jnp.einsum('thk,thkd->td', act, peer_v[idb])

    y = lax.map(expert_block, (xt.reshape(nblk, PEER_TOKEN_BLOCK, D),
                               ids.reshape(nblk, PEER_TOKEN_BLOCK, PEER_HEADS, PEER_TOPK),
                               g.reshape(nblk, PEER_TOKEN_BLOCK, PEER_HEADS, PEER_TOPK)))
    return y.reshape(B, T, D)


def setup_inputs(seed: int = 0) -> dict:
    key = jax.random.key(seed)
    ks = jax.random.split(key, 26)
    f32 = jnp.float32

    def nrm(k, shape, scale):
        return jax.random.normal(k, shape, f32) * scale

    def gain(k, shape):
        return 1.0 + 0.02 * jax.random.normal(k, shape, f32)

    u = jax.random.uniform(ks[10], (DEPTH, D_LRU), f32, 0.9, 0.999)
    a0 = u ** (1.0 / LRU_C)
    lru_lambda = jnp.log(a0) - jnp.log1p(-a0)
    return {
        'x': jax.random.normal(ks[0], (BATCH, SEQ, D_MODEL), f32),
        'p': jax.random.normal(ks[1], (DEPTH, BATCH, SEQ, PLE_DIM), f32),
        'g_mix': gain(ks[2], (DEPTH, D_MODEL)),
        'w_in': nrm(ks[3], (DEPTH, D_MODEL, D_IN_PROJ), D_MODEL ** -0.5),
        'conv_w': nrm(ks[4], (DEPTH, CONV_WIDTH, D_LRU), CONV_WIDTH ** -0.5),
        'conv_b': nrm(ks[5], (DEPTH, D_LRU), 0.02),
        'w_rg': nrm(ks[6], (DEPTH, LRU_BLOCKS, LRU_BLOCK_DIM, LRU_BLOCK_DIM), LRU_BLOCK_DIM ** -0.5),
        'b_rg': nrm(ks[7], (DEPTH, D_LRU), 0.02),
        'w_ig': nrm(ks[8], (DEPTH, LRU_BLOCKS, LRU_BLOCK_DIM, LRU_BLOCK_DIM), LRU_BLOCK_DIM ** -0.5),
        'b_ig': nrm(ks[9], (DEPTH, D_LRU), 0.02),
        'lru_lambda': lru_lambda,
        'g_lru_out': gain(ks[11], (DEPTH, D_LRU)),
        'g_attn_out': gain(ks[12], (DEPTH, D_ATTN)),
        'w_out': nrm(ks[13], (DEPTH, D_MIX, D_MODEL), D_MIX ** -0.5),
        'rel_bias': nrm(ks[14], (REL_BUCKETS, N_ATT_HEADS), 0.5),
        'g_ffn': gain(ks[15], (DEPTH, D_MODEL)),
        'peer_wq': nrm(ks[16], (DEPTH, D_MODEL, PEER_HEADS * PEER_QDIM), D_MODEL ** -0.5),
        'peer_k1': nrm(ks[17], (DEPTH, PEER_NKEYS, PEER_QDIM // 2), (PEER_QDIM // 2) ** -0.5),
        'peer_k2': nrm(ks[18], (DEPTH, PEER_NKEYS, PEER_QDIM // 2), (PEER_QDIM // 2) ** -0.5),
        'peer_u': nrm(ks[19], (DEPTH, PEER_EXPERTS, D_MODEL), D_MODEL ** -0.5),
        'peer_v': nrm(ks[20], (DEPTH, PEER_EXPERTS, D_MODEL), PEER_HEADS ** -0.5),
        'g_ple': gain(ks[21], (DEPTH, D_MODEL)),
        'w_ple_gate': nrm(ks[22], (DEPTH, D_MODEL, D_MODEL), D_MODEL ** -0.5),
        'w_ple_proj': nrm(ks[23], (DEPTH, PLE_DIM, D_MODEL), PLE_DIM ** -0.5),
        'g_final': gain(ks[24], (D_MODEL,)),
    }


def reference(x, p, g_mix, w_in, conv_w, conv_b, w_rg, b_rg, w_ig, b_ig, lru_lambda,
              g_lru_out, g_attn_out, w_out, rel_bias, g_ffn, peer_wq, peer_k1, peer_k2,
              peer_u, peer_v, g_ple, w_ple_gate, w_ple_proj, g_final):
    h = x
    for i in range(DEPTH):
        h = h + hybrid_mixer(rmsnorm(h, g_mix[i]), w_in[i], conv_w[i], conv_b[i], w_rg[i], b_rg[i],
                             w_ig[i], b_ig[i], lru_lambda[i], g_lru_out[i], g_attn_out[i], w_out[i],
                             rel_bias)
        h = h + peer_ffn(rmsnorm(h, g_ffn[i]), peer_wq[i], peer_k1[i], peer_k2[i], peer_u[i], peer_v[i])
        h = h + jax.nn.sigmoid(rmsnorm(h, g_ple[i]) @ w_ple_gate[i]) * (p[i] @ w_ple_proj[i])
    return rmsnorm(h, g_final)
```

```cpp
#include <hip/hip_runtime.h>
#include <cstdio>
#include <cstdint>
#define MK_N_LAUNCHES 10
namespace pg8 {
#define PG8_LAS __attribute__((address_space(3)))
typedef unsigned short bf16_t;
typedef short bf16x8 __attribute__((ext_vector_type(8)));
typedef float f32x4 __attribute__((ext_vector_type(4)));
typedef unsigned u32x4 __attribute__((ext_vector_type(4)));
constexpr int BM = 256, BK = 64, HALF = 128, HTB = HALF * BK * 2  , STAGE_BYTES = 8 * HTB, NXCD = 8, WGM = 8;

__host__ __device__ __forceinline__ int lds_byte(int r, int c) { const int st = (r >> 4) * 2 + (c >> 5), rr = r & 15, cc = c & 31, ob = rr * 64 + cc * 2; return st * 1024 + (ob ^ (((ob >> 9) & 1) << 5)); }
__host__ __device__ __forceinline__ void stage_rc(int b, int& R, int& C) { const int st = b / 1024, sb = b % 1024, swz = sb ^ (((sb >> 9) & 1) << 5); R = (st >> 1) * 16 + swz / 64; C = (st & 1) * 32 + (swz % 64) / 2; }
__host__ __device__ __forceinline__ int perm32(int rho) { const int n = rho >> 4, i = rho & 15; return 8 * (i >> 2) + 4 * n + (i & 3); }

struct Unit { int pm, pn; };
struct Gemm { const bf16_t* A; const bf16_t* Bt; int M, N, K; };

struct StaticOrder {
    int nM, nN, nwg, G, c;
    __host__ __device__ void init(int M, int N, int G_, int c_) { nM = M / BM; nN = N / BM; nwg = nM * nN; G = G_; c = c_; }
    __host__ __device__ bool next(int i, Unit& u) const {
        const long L = (long)i * G + c; if (L >= nwg) return false;
        int wgid = (int)L; { const int q = nwg / NXCD, r = nwg % NXCD, xcd = wgid % NXCD, off = wgid / NXCD; wgid = (xcd < r ? xcd * (q + 1) : r * (q + 1) + (xcd - r) * q) + off; }
        const int nig = WGM * nN, gid = wgid / nig, fm = gid * WGM, gsz = (nM - fm) < WGM ? (nM - fm) : WGM;
        u.pm = fm + ((wgid % nig) % gsz); u.pn = (wgid % nig) / gsz; return true;
    }
    __device__ __forceinline__ void a_ready(const Unit&) const {}
    __device__ __forceinline__ void done(const Unit&) const {}
};

__device__ __forceinline__ unsigned cvt_pk_bf16(float lo, float hi) { unsigned r; asm volatile("v_cvt_pk_bf16_f32 %0, %1, %2" : "=v"(r) : "v"(lo), "v"(hi)); return r; }
typedef float f32x2 __attribute__((ext_vector_type(2)));
__device__ __forceinline__ f32x2 gelu_pk(f32x2 v) {
    const f32x2 av = __builtin_elementwise_abs(v), d = av * 0.2316418882f + 1.0f;
    f32x2 t; t.x = __builtin_amdgcn_rcpf(d.x); t.y = __builtin_amdgcn_rcpf(d.y);
    f32x2 q = t * 0.5307027145f + (-0.7265760135f); q = q * t + 0.7107068705f; q = q * t + (-0.142248368f); q = q * t + 0.127414796f; q = q * t;
    const f32x2 s = (v * v) * (-0.72134752044f);
    f32x2 e; e.x = __builtin_amdgcn_exp2f(s.x); e.y = __builtin_amdgcn_exp2f(s.y);
    const f32x2 m = v * (q * e), r = v - m;
    f32x2 o; o.x = v.x < 0.f ? m.x : r.x; o.y = v.y < 0.f ? m.y : r.y; return o;
}

template <int ACT  > struct EpiBf16 {
    static constexpr bool PERM = true, AFTER_DRAIN = false; static_assert(ACT == 0 || ACT == 1, "EpiBf16: ACT is 0 (none) or 1 (gelu_pk)");
    bf16_t* O; int ldc; const float* bias; int split_cols; size_t split_stride; float scale0;
    __device__ __forceinline__ void operator()(const f32x4 (&acc)[2][2][4][2], const Unit& u, int wr, int wc, int fr, int fq) const {
        const int row0 = u.pm * BM + wr * 64 + fr; int colt = u.pn * BM; bf16_t* base = O;
        float sc = 1.f; if (split_cols) { const int t = colt / split_cols; base += (size_t)t * split_stride; colt -= t * split_cols; if (t == 0) sc = scale0; }
        const int col0 = colt + wc * 32 + 8 * fq, bcol0 = u.pn * BM + wc * 32 + 8 * fq;
        f32x4 bv[2][2];
#pragma unroll
        for (int bj = 0; bj < 2; ++bj)
#pragma unroll
            for (int n = 0; n < 2; ++n) bv[bj][n] = bias ? *(const f32x4*)(bias + bcol0 + bj * HALF + 4 * n) : (f32x4){0.f, 0.f, 0.f, 0.f};
#pragma unroll
        for (int ai = 0; ai < 2; ++ai)
#pragma unroll
            for (int m = 0; m < 4; ++m) { bf16_t* rowp = base + (size_t)(row0 + ai * HALF + m * 16) * ldc + col0;
#pragma unroll
                for (int bj = 0; bj < 2; ++bj) { f32x4 v0 = acc[ai][bj][m][0] + bv[bj][0], v1 = acc[ai][bj][m][1] + bv[bj][1];
                    if (ACT == 1) { f32x2 a = gelu_pk((f32x2){v0[0], v0[1]}), b = gelu_pk((f32x2){v0[2], v0[3]}), c = gelu_pk((f32x2){v1[0], v1[1]}), d = gelu_pk((f32x2){v1[2], v1[3]});
                        v0 = (f32x4){a.x, a.y, b.x, b.y}; v1 = (f32x4){c.x, c.y, d.x, d.y}; }
                    v0 = v0 * sc; v1 = v1 * sc; u32x4 w; w.x = cvt_pk_bf16(v0[0], v0[1]); w.y = cvt_pk_bf16(v0[2], v0[3]); w.z = cvt_pk_bf16(v1[0], v1[1]); w.w = cvt_pk_bf16(v1[2], v1[3]);
                    *(u32x4*)(rowp + bj * HALF) = w; } }
    }
};
template <class Epi, class Sched, bool ALIGN_EPI = false, bool SP2 = false>
__device__ __forceinline__ void gemm_phase(PG8_LAS unsigned char* lds, const Gemm g, const Sched& S, const Epi& E) {
    const int tid = threadIdx.x, wid = __builtin_amdgcn_readfirstlane(tid >> 6), lane = tid & 63, wr = wid >> 2, wc = wid & 3, fr = lane & 15, fq = lane >> 4;
    const int K = g.K, nt = K / BK;
    unsigned voffA[2], voffB[2];
#pragma unroll
    for (int i = 0; i < 2; ++i) { int R, C; stage_rc(tid * 16 + i * 8192, R, C); const int Rb = Epi::PERM ? ((R & ~31) + perm32(R & 31)) : R;
        voffA[i] = (unsigned)(R * K + C) * 2u; voffB[i] = (unsigned)(Rb * K + C) * 2u; }
    const size_t kstep = (size_t)(BK * 2);
    const size_t hstep = (size_t)HALF * K * 2;
    const size_t tstep = 2 * hstep;
    const unsigned ldsw = (unsigned)wid * 1024u;
    const int aoff = lds_byte(wr * 64 + fr, fq * 8), boff = lds_byte(wc * 32 + fr, fq * 8);
#define PG8_SA(b, h) (((b) * 2 + (h)) * HTB)
#define PG8_SB(b, h) ((4 + (b) * 2 + (h)) * HTB)
#define PG8_STAGE(bufoff, gbase, voff) do { _Pragma("unroll") for (int _i = 0; _i < 2; ++_i) \
        __builtin_amdgcn_global_load_lds((const unsigned*)((const char*)(gbase) + (voff)[_i]), (PG8_LAS unsigned*)(lds + (bufoff) + ldsw + _i * 8192), 16, 0, 0); } while (0)
#define PG8_LDA(dst, b, h) do { _Pragma("unroll") for (int m = 0; m < 4; ++m) _Pragma("unroll") for (int k = 0; k < 2; ++k) dst[m][k] = *(const PG8_LAS bf16x8*)(lds + PG8_SA(b, h) + aoff + m * 2048 + k * 1024); } while (0)
#define PG8_LDB(dst, b, h) do { _Pragma("unroll") for (int n = 0; n < 2; ++n) _Pragma("unroll") for (int k = 0; k < 2; ++k) dst[n][k] = *(const PG8_LAS bf16x8*)(lds + PG8_SB(b, h) + boff + n * 2048 + k * 1024); } while (0)
#define PG8_MMA(ai, bj, At, Bt) do { __builtin_amdgcn_s_setprio(1); _Pragma("unroll") for (int m = 0; m < 4; ++m) _Pragma("unroll") for (int n = 0; n < 2; ++n) _Pragma("unroll") for (int k = 0; k < 2; ++k) \
        acc[ai][bj][m][n] = __builtin_amdgcn_mfma_f32_16x16x32_bf16(Bt[n][k], At[m][k], acc[ai][bj][m][n], 0, 0, 0); __builtin_amdgcn_s_setprio(0); } while (0)
#define PG8_WAIT_V(n) asm volatile("s_waitcnt vmcnt(" #n ")" ::: "memory")
#define PG8_WAIT_L(n) asm volatile("s_waitcnt lgkmcnt(" #n ")" ::: "memory")
#define PG8_BAR __builtin_amdgcn_s_barrier()
#define PG8_SCHED __builtin_amdgcn_sched_barrier(0)
    Unit cur, nxt; int ui = 0;
    if (!S.next(0, cur)) return;
    f32x4 acc[2][2][4][2];
#pragma unroll
    for (int a = 0; a < 2; ++a)
#pragma unroll
        for (int b = 0; b < 2; ++b)
#pragma unroll
            for (int m = 0; m < 4; ++m)
#pragma unroll
                for (int n = 0; n < 2; ++n) acc[a][b][m][n] = (f32x4){0.f, 0.f, 0.f, 0.f};
    bf16x8 At[4][2], B0[2][2], B1[2][2];
    const char* cA = (const char*)g.A + (size_t)cur.pm * tstep; const char* cB = (const char*)g.Bt + (size_t)cur.pn * tstep;
    S.a_ready(cur);
    if constexpr (SP2) {
        PG8_STAGE(PG8_SB(0, 0), cB, voffB); PG8_STAGE(PG8_SB(0, 1), cB + hstep, voffB); PG8_STAGE(PG8_SA(0, 0), cA, voffA); PG8_STAGE(PG8_SA(0, 1), cA + hstep, voffA);
        if (wr == 1) PG8_BAR;
        PG8_WAIT_V(2); PG8_BAR;
        PG8_STAGE(PG8_SB(1, 0), cB + kstep, voffB); PG8_STAGE(PG8_SA(1, 0), cA + kstep, voffA); PG8_STAGE(PG8_SB(1, 1), cB + hstep + kstep, voffB);
        PG8_WAIT_V(6); PG8_BAR;
    } else {
        PG8_STAGE(PG8_SB(0, 0), cB, voffB); PG8_STAGE(PG8_SA(0, 0), cA, voffA); PG8_STAGE(PG8_SB(0, 1), cB + hstep, voffB); PG8_STAGE(PG8_SA(0, 1), cA + hstep, voffA);
        if (wr == 1) PG8_BAR;
        PG8_WAIT_V(4); PG8_BAR;
        PG8_STAGE(PG8_SB(1, 0), cB + kstep, voffB); PG8_STAGE(PG8_SA(1, 0), cA + kstep, voffA); PG8_STAGE(PG8_SB(1, 1), cB + hstep + kstep, voffB);
        PG8_WAIT_V(6); PG8_BAR;
    }
    for (;;) {
        const bool has_next = S.next(ui + 1, nxt);
        const char* nA = has_next ? (const char*)g.A + (size_t)nxt.pm * tstep : cA; const char* nB = has_next ? (const char*)g.Bt + (size_t)nxt.pn * tstep : cB;
        for (int t = 0; t < nt; t += 2) {
            const bool last = (t == nt - 2);
            const char* a1 = cA + (size_t)(t + 1) * kstep;
            const char* a2 = last ? nA : cA + (size_t)(t + 2) * kstep; const char* b2 = last ? nB : cB + (size_t)(t + 2) * kstep;
            const char* a3 = a2 + kstep; const char* b3 = b2 + kstep;
            if (last && has_next) S.a_ready(nxt);
            if constexpr (SP2) {
            PG8_LDB(B0, 0, 0); PG8_LDB(B1, 0, 1); PG8_SCHED; PG8_LDA(At, 0, 0); PG8_STAGE(PG8_SA(1, 1), a1 + hstep, voffA);
            PG8_WAIT_V(8); PG8_WAIT_L(0); PG8_BAR; PG8_MMA(0, 0, At, B0); PG8_MMA(0, 1, At, B1); PG8_BAR; PG8_SCHED;
            PG8_LDA(At, 0, 1); PG8_STAGE(PG8_SB(0, 0), b2, voffB); PG8_STAGE(PG8_SB(0, 1), b2 + hstep, voffB); PG8_STAGE(PG8_SA(0, 0), a2, voffA);
            PG8_WAIT_V(8); PG8_WAIT_L(0); PG8_BAR; PG8_MMA(1, 0, At, B0); PG8_MMA(1, 1, At, B1); PG8_BAR; PG8_SCHED;
            PG8_LDB(B0, 1, 0); PG8_LDB(B1, 1, 1); PG8_SCHED; PG8_LDA(At, 1, 0); PG8_STAGE(PG8_SA(0, 1), a2 + hstep, voffA);
            PG8_WAIT_V(8); PG8_WAIT_L(0); PG8_BAR; PG8_MMA(0, 0, At, B0); PG8_MMA(0, 1, At, B1); PG8_BAR; PG8_SCHED;
            PG8_LDA(At, 1, 1); PG8_STAGE(PG8_SB(1, 0), b3, voffB); PG8_STAGE(PG8_SB(1, 1), b3 + hstep, voffB); PG8_STAGE(PG8_SA(1, 0), a3, voffA);
            PG8_WAIT_V(8); PG8_WAIT_L(0); PG8_BAR; PG8_MMA(1, 0, At, B0); PG8_MMA(1, 1, At, B1); PG8_BAR; PG8_SCHED;
            } else {
            PG8_LDB(B0, 0, 0); PG8_SCHED; PG8_LDA(At, 0, 0); PG8_STAGE(PG8_SA(1, 1), a1 + hstep, voffA);
            PG8_WAIT_L(8); PG8_BAR; PG8_WAIT_L(0); PG8_MMA(0, 0, At, B0); PG8_BAR; PG8_SCHED;
            PG8_LDB(B1, 0, 1); PG8_STAGE(PG8_SB(0, 0), b2, voffB);
            PG8_BAR; PG8_WAIT_L(0); PG8_MMA(0, 1, At, B1); PG8_BAR;
            PG8_LDA(At, 0, 1); PG8_STAGE(PG8_SA(0, 0), a2, voffA);
            PG8_BAR; PG8_WAIT_L(0); PG8_MMA(1, 0, At, B0); PG8_BAR; PG8_SCHED;
            PG8_STAGE(PG8_SB(0, 1), b2 + hstep, voffB);
            PG8_WAIT_V(6); PG8_BAR; PG8_MMA(1, 1, At, B1); PG8_BAR;
            PG8_LDB(B0, 1, 0); PG8_SCHED; PG8_LDA(At, 1, 0); PG8_STAGE(PG8_SA(0, 1), a2 + hstep, voffA);
            PG8_WAIT_L(8); PG8_BAR; PG8_WAIT_L(0); PG8_MMA(0, 0, At, B0); PG8_BAR; PG8_SCHED;
            PG8_LDB(B1, 1, 1); PG8_STAGE(PG8_SB(1, 0), b3, voffB);
            PG8_BAR; PG8_WAIT_L(0); PG8_MMA(0, 1, At, B1); PG8_BAR;
            PG8_LDA(At, 1, 1); PG8_STAGE(PG8_SA(1, 0), a3, voffA);
            PG8_BAR; PG8_WAIT_L(0); PG8_MMA(1, 0, At, B0); PG8_BAR; PG8_SCHED;
            PG8_STAGE(PG8_SB(1, 1), b3 + hstep, voffB);
            PG8_WAIT_V(6); PG8_BAR; PG8_MMA(1, 1, At, B1); PG8_BAR;
            }
        }
        if constexpr (ALIGN_EPI) { if (wr == 0) PG8_BAR; }
        if constexpr (!Epi::AFTER_DRAIN) { E(acc, cur, wr, wc, fr, fq); S.done(cur); }
        if (!has_next) break;
#pragma unroll
        for (int a = 0; a < 2; ++a)
#pragma unroll
            for (int b = 0; b < 2; ++b)
#pragma unroll
                for (int m = 0; m < 4; ++m)
#pragma unroll
                    for (int n = 0; n < 2; ++n) acc[a][b][m][n] = (f32x4){0.f, 0.f, 0.f, 0.f};
        cur = nxt; cA = nA; cB = nB; ++ui;
        if constexpr (ALIGN_EPI) { if (wr == 1) PG8_BAR; }
    }
    PG8_WAIT_V(0);
    if constexpr (!ALIGN_EPI) { if (wr == 0) PG8_BAR; }
    PG8_BAR;
    if constexpr (Epi::AFTER_DRAIN) { E.fused(acc, cur, wr, wc, fr, fq, lds, wid, lane); S.done(cur); }
#undef PG8_SA
#undef PG8_SB
#undef PG8_STAGE
#undef PG8_LDA
#undef PG8_LDB
#undef PG8_MMA
#undef PG8_WAIT_V
#undef PG8_WAIT_L
#undef PG8_BAR
#undef PG8_SCHED
}
}
namespace pg8 {
typedef unsigned u32x2 __attribute__((ext_vector_type(2)));
__device__ __forceinline__ float ssq16(const float* p) {
    const f32x4 a = *(const f32x4*)p, b = *(const f32x4*)(p + 4), c = *(const f32x4*)(p + 8), d = *(const f32x4*)(p + 12);
    return ((a[0] + a[1]) + (a[2] + a[3])) + ((b[0] + b[1]) + (b[2] + b[3])) + ((c[0] + c[1]) + (c[2] + c[3])) + ((d[0] + d[1]) + (d[2] + d[3]));
}
struct EpiResid {
    static constexpr bool PERM = false, AFTER_DRAIN = false;
    const float* resid; float* out; bf16_t* ob; float* ssq;
    __device__ __forceinline__ void operator()(const f32x4 (&acc)[2][2][4][2], const Unit& u, int wr, int wc, int fr, int fq) const {
        const int row0 = u.pm * BM + wr * 64 + fr, col0 = u.pn * BM + wc * 32 + 4 * fq;
#pragma unroll
        for (int ai = 0; ai < 2; ++ai)
#pragma unroll
            for (int m = 0; m < 4; ++m) { const int row = row0 + ai * HALF + m * 16; const size_t off = (size_t)row * 1024 + col0; float ss = 0.f;
#pragma unroll
                for (int bj = 0; bj < 2; ++bj)
#pragma unroll
                    for (int n = 0; n < 2; ++n) { const int co = bj * HALF + n * 16; const f32x4 v = acc[ai][bj][m][n] + *(const f32x4*)(resid + off + co);
                        *(f32x4*)(out + off + co) = v; ss += (v[0] * v[0] + v[1] * v[1]) + (v[2] * v[2] + v[3] * v[3]);
                        u32x2 w; w.x = cvt_pk_bf16(v[0], v[1]); w.y = cvt_pk_bf16(v[2], v[3]); *(u32x2*)(ob + off + co) = w; }
                ss += __shfl_xor(ss, 16); ss += __shfl_xor(ss, 32);
                if (fq == 0) ssq[(size_t)row * 16 + u.pn * 4 + wc] = ss; }
    }
};
struct EpiScore {
    static constexpr bool PERM = true, AFTER_DRAIN = false;
    _Float16* S; const float* ssq; float eps;
    __device__ __forceinline__ void operator()(const f32x4 (&acc)[2][2][4][2], const Unit& u, int wr, int wc, int fr, int fq) const {
        typedef _Float16 h2 __attribute__((ext_vector_type(2)));
        const int row0 = u.pm * BM + wr * 64 + fr, col0 = u.pn * BM + wc * 32 + 8 * fq;
#pragma unroll
        for (int ai = 0; ai < 2; ++ai)
#pragma unroll
            for (int m = 0; m < 4; ++m) { const int row = row0 + ai * HALF + m * 16;
                const float rinv = __builtin_amdgcn_rsqf(ssq16(ssq + (size_t)row * 16) * (1.0f / 1024.0f) + eps);
                _Float16* rowp = S + (size_t)row * 2048 + col0;
#pragma unroll
                for (int bj = 0; bj < 2; ++bj) { const f32x4 v0 = acc[ai][bj][m][0] * rinv, v1 = acc[ai][bj][m][1] * rinv;
                    u32x4 w; h2 t;
                    t.x = (_Float16)v0[0]; t.y = (_Float16)v0[1]; w.x = __builtin_bit_cast(unsigned, t);
                    t.x = (_Float16)v0[2]; t.y = (_Float16)v0[3]; w.y = __builtin_bit_cast(unsigned, t);
                    t.x = (_Float16)v1[0]; t.y = (_Float16)v1[1]; w.z = __builtin_bit_cast(unsigned, t);
                    t.x = (_Float16)v1[2]; t.y = (_Float16)v1[3]; w.w = __builtin_bit_cast(unsigned, t);
                    *(u32x4*)(rowp + bj * HALF) = w; } }
    }
};
struct EpiPle {
    static constexpr bool PERM = false, AFTER_DRAIN = false;
    float* io; const bf16_t* P; const float* rinv; float* ssq;
    __device__ __forceinline__ void operator()(const f32x4 (&acc)[2][2][4][2], const Unit& u, int wr, int wc, int fr, int fq) const {
        const int row0 = u.pm * BM + wr * 64 + fr, col0 = u.pn * BM + wc * 32 + 4 * fq;
#pragma unroll
        for (int ai = 0; ai < 2; ++ai)
#pragma unroll
            for (int m = 0; m < 4; ++m) { const int row = row0 + ai * HALF + m * 16; const size_t off = (size_t)row * 1024 + col0; float ss = 0.f; const float ri = rinv[row];
#pragma unroll
                for (int bj = 0; bj < 2; ++bj)
#pragma unroll
                    for (int n = 0; n < 2; ++n) { const int co = bj * HALF + n * 16; const f32x4 a = acc[ai][bj][m][n] * ri; const f32x4 h = *(const f32x4*)(io + off + co);
                        const u32x2 pw = *(const u32x2*)(P + off + co);
                        f32x4 pv; pv[0] = __uint_as_float(pw.x << 16); pv[1] = __uint_as_float(pw.x & 0xffff0000u); pv[2] = __uint_as_float(pw.y << 16); pv[3] = __uint_as_float(pw.y & 0xffff0000u);
                        f32x4 v;
#pragma unroll
                        for (int j = 0; j < 4; ++j) v[j] = h[j] + pv[j] / (1.0f + __expf(-a[j]));
                        *(f32x4*)(io + off + co) = v; ss += (v[0] * v[0] + v[1] * v[1]) + (v[2] * v[2] + v[3] * v[3]); }
                ss += __shfl_xor(ss, 16); ss += __shfl_xor(ss, 32);
                if (fq == 0) ssq[(size_t)row * 16 + u.pn * 4 + wc] = ss; }
    }
};
}
#ifndef PG8_SP2
#define PG8_SP2 true
#endif
#ifndef PG8_ALIGN
#define PG8_ALIGN true
#endif
#define GAS __attribute__((address_space(1)))
#define LAS __attribute__((address_space(3)))
typedef unsigned short bf16;
typedef unsigned v4u __attribute__((ext_vector_type(4)));
typedef float f32x4 __attribute__((ext_vector_type(4)));
typedef short bf16x8 __attribute__((ext_vector_type(8)));
typedef GAS unsigned gu32;
typedef GAS unsigned long long gu64;
#define RLX_AGENT __ATOMIC_RELAXED, __HIP_MEMORY_SCOPE_AGENT
#define LDS_WAIT() asm volatile("s_waitcnt lgkmcnt(0)" ::: "memory")
#define VM_WAIT() asm volatile("s_waitcnt vmcnt(0)" ::: "memory")
__device__ __forceinline__ unsigned long long rt() { return __builtin_amdgcn_s_memrealtime(); }
__device__ __forceinline__ unsigned f2bf(float f) { unsigned u = __builtin_bit_cast(unsigned, f); return (u + 0x7fffu + ((u >> 16) & 1u)) >> 16; }
__device__ __forceinline__ unsigned pk2(float lo, float hi) { return f2bf(lo) | (f2bf(hi) << 16); }

#define XB_TMO      128
#define XB_XCNT(j)  (256  + 64 * (j))
#define XB_XSUB(j)  (1280 + 64 * (j))
#define XB_XGEN(j)  (2304 + 64 * (j))
#define XB_TOP      3328
#define XB_TOPGEN   3392
#define XCD_BAR_WORDS 3456
#define XB_SPIN_CAP (1u << 18)

__device__ __forceinline__ unsigned xb_ld(unsigned* p)              { return __hip_atomic_load(p, __ATOMIC_RELAXED, __HIP_MEMORY_SCOPE_AGENT); }
__device__ __forceinline__ unsigned xb_add(unsigned* p, unsigned v) { return __hip_atomic_fetch_add(p, v, __ATOMIC_RELAXED, __HIP_MEMORY_SCOPE_AGENT); }
__device__ __forceinline__ unsigned xb_xcc_id() { return (unsigned)__builtin_amdgcn_s_getreg((3 << 11) | 20) & 0xFu; }
#define XB_SPIN(cond, bar) do { unsigned _sp = 0; while (cond) { __builtin_amdgcn_s_sleep(1); \
    if ((++_sp & 255u) == 0u) { if (xb_ld(&(bar)[XB_TMO])) break; if (_sp > XB_SPIN_CAP) { atomicAdd(&(bar)[XB_TMO], 1u); break; } } } } while (0)

struct XcdBarrier {
    unsigned* bar; unsigned x;
    volatile LAS unsigned* st;
};

__device__ __forceinline__ XcdBarrier xcd_barrier_post(unsigned* bar, volatile LAS unsigned* st) {
    XcdBarrier b; b.bar = bar; b.x = xb_xcc_id(); b.st = st;
    if (threadIdx.x == 0) (void)xb_add(&bar[XB_XCNT(b.x)], 1u);
    return b;
}
__device__ __forceinline__ void xcd_barrier_complete(unsigned* bar, unsigned x, unsigned& nloc, unsigned& nx) {
    const unsigned G = gridDim.x * gridDim.y * gridDim.z;
    unsigned sum, cnt, mine, sp = 0u;
    for (;;) {
        sum = 0u; cnt = 0u; mine = 0u;
#pragma unroll
        for (unsigned j = 0; j < 16; ++j) { const unsigned c = xb_ld(&bar[XB_XCNT(j)]); sum += c; cnt += (c > 0u) ? 1u : 0u; mine = (j == x) ? c : mine; }
        if (sum == G) break;
        __builtin_amdgcn_s_sleep(1);
        if ((++sp & 255u) == 0u) { if (xb_ld(&bar[XB_TMO])) break; if (sp > XB_SPIN_CAP) { atomicAdd(&bar[XB_TMO], 1u); break; } }
    }
    nloc = mine > 0u ? mine : 1u; nx = cnt > 0u ? cnt : 1u;
}

__device__ __forceinline__ void xcd_barrier(const XcdBarrier& b) {
    asm volatile("s_waitcnt vmcnt(0)" ::: "memory");
    __syncthreads();
    if (threadIdx.x == 0) {
        unsigned* bar = b.bar;
        __builtin_amdgcn_s_waitcnt(0);
        unsigned nloc = b.st[0], nx = b.st[1];
        if (nloc == 0u) { xcd_barrier_complete(bar, b.x, nloc, nx); b.st[0] = nloc; b.st[1] = nx; }
        const unsigned old = xb_add(&bar[XB_XSUB(b.x)], 1u);
        const unsigned gen = old / nloc;
        if (old + 1u == (gen + 1u) * nloc) {
            __builtin_amdgcn_fence(__ATOMIC_RELEASE, "agent");
            asm volatile("s_waitcnt vmcnt(0)" ::: "memory");
            const unsigned og = xb_add(&bar[XB_TOP], 1u);
            const unsigned tg = og / nx;
            if (og + 1u == (tg + 1u) * nx) xb_add(&bar[XB_TOPGEN], 1u);
            else XB_SPIN(xb_ld(&bar[XB_TOPGEN]) == tg, bar);
            __builtin_amdgcn_fence(__ATOMIC_ACQUIRE, "agent");
            xb_add(&bar[XB_XGEN(b.x)], 1u);
            asm volatile("s_waitcnt vmcnt(0)" ::: "memory");
        } else {
            XB_SPIN(xb_ld(&bar[XB_XGEN(b.x)]) == gen, bar);
            __builtin_amdgcn_fence(__ATOMIC_ACQUIRE, "agent");
            asm volatile("s_waitcnt vmcnt(0)" ::: "memory");
        }
    }
    __syncthreads();
}
constexpr int NWAVES = 8, NT = NWAVES * 64;
constexpr int D = 1024, SEQ = 2048, NB = 8, M = NB * SEQ;
constexpr int DLRU = 512, NH = 8, HD = 64, DIN = 2560, PLE = 256;
constexpr int ZC_X = 0, ZC_G = 512, ZC_Q = 1024, ZC_K = 1536, ZC_V = 2048;
constexpr int NKEY = 128, NSLOT = 128;
constexpr int CH = 64, NCH = SEQ / CH;
constexpr float EPS = 1e-6f;
#ifndef MK_N_LAUNCHES
#define MK_N_LAUNCHES 1
#endif
constexpr int NPHASE = 10;
constexpr int N_LAUNCHES = MK_N_LAUNCHES;

constexpr size_t MiB = 1u << 20;
constexpr size_t WS_CTL = 0, CTL_ZERO_BYTES = 64 * 1024;
constexpr size_t WS_WIN = 1 * MiB, WS_WOUT = 6 * MiB, WS_WCOMB = 8 * MiB, WS_WGATE = 12 * MiB, WS_WPROJ = 14 * MiB;
constexpr size_t WS_SSQ1 = 15 * MiB, WS_RINV2 = 16 * MiB, WS_SSQ3 = 17 * MiB, WS_LRUS = 18 * MiB;
constexpr size_t WS_IDS = 20 * MiB, WS_GW = 28 * MiB;
constexpr size_t WS_A0 = 40 * MiB, WS_A1 = 72 * MiB, WS_Z = 104 * MiB, WS_PU = 184 * MiB, WS_PV = 216 * MiB, WS_P16 = 248 * MiB, WS_END = 256 * MiB;
constexpr int CW_BAR = 4096;

constexpr int RING_BYTES = 131072, LDSCTL_OFF = RING_BYTES, MISC_OFF = LDSCTL_OFF + 320, LDS_BYTES = 147456;

__device__ __forceinline__ float bf2f(unsigned short b) { return __uint_as_float(((unsigned)b) << 16); }
__device__ __forceinline__ float bflo(unsigned w) { return __uint_as_float(w << 16); }
__device__ __forceinline__ float bfhi(unsigned w) { return __uint_as_float(w & 0xffff0000u); }
__device__ __forceinline__ float wave_sum(float v) {
#pragma unroll
    for (int o = 1; o < 64; o <<= 1) v += __shfl_xor(v, o);
    return v;
}
__device__ __forceinline__ float wave_max(float v) {
#pragma unroll
    for (int o = 1; o < 64; o <<= 1) v = fmaxf(v, __shfl_xor(v, o));
    return v;
}
__device__ __forceinline__ float gelu_tanh(float x) {
    const float u = 0.7978845608028654f * (x + 0.044715f * x * x * x);
    const float e = __expf(2.0f * u);
    const float th = 1.0f - 2.0f / (e + 1.0f);
    return 0.5f * x * (1.0f + th);
}
__device__ __forceinline__ float sigmoidf_(float x) { return 1.0f / (1.0f + __expf(-x)); }
__device__ __forceinline__ int t5_bucket(int n) {
    if (n < 16) return n;
    const int large = 16 + (int)(logf((float)n / 16.0f) / 4.852030263919617f * 16.0f);
    return large < 31 ? large : 31;
}

__device__ __forceinline__ void p0_transpose_item(const float* W, int K, int N, bf16* WT, LAS float* scr, int item, int lane, const float* gk, int qlo, int qhi) {
    const int nblk = N / 32, kb = item / nblk, nb = item % nblk, k0 = 64 * kb, n0 = 32 * nb;
#pragma unroll 8
    for (int i = 0; i < 32; ++i) { const int kk = 2 * i + (lane >> 5); float v = W[(size_t)(k0 + kk) * N + n0 + (lane & 31)]; if (gk) v *= gk[k0 + kk]; scr[kk * 33 + (lane & 31)] = v; }
    LDS_WAIT(); asm volatile("" ::: "memory");
    const int c = lane & 7;
#pragma unroll
    for (int j = 0; j < 4; ++j) { const int n = (lane >> 3) + 8 * j; const LAS float* s = scr + (8 * c) * 33 + n; const float sc = (n0 + n >= qlo && n0 + n < qhi) ? 0.125f : 1.0f;
        v4u o; o.x = pk2(s[0 * 33] * sc, s[1 * 33] * sc); o.y = pk2(s[2 * 33] * sc, s[3 * 33] * sc); o.z = pk2(s[4 * 33] * sc, s[5 * 33] * sc); o.w = pk2(s[6 * 33] * sc, s[7 * 33] * sc);
        *(GAS v4u*)(WT + (size_t)(n0 + n) * K + k0 + 8 * c) = o; }
    LDS_WAIT(); asm volatile("" ::: "memory");
}

struct Args { const float* in[25]; float* out; unsigned char* ws; int ph_lo, ph_hi; };

__global__ void __launch_bounds__(NT, 2) hybrid_fwd(Args args) {
    extern __shared__ __attribute__((aligned(16))) unsigned char lds_raw[];
    LAS unsigned char* lds = (LAS unsigned char*)lds_raw;
    const int tid = threadIdx.x, lane = tid & 63, wave = __builtin_amdgcn_readfirstlane(tid >> 6);
    const int G = gridDim.x, bx = blockIdx.x;
    const int gw = bx * NWAVES + wave, NGW = G * NWAVES;
    unsigned char* ws = args.ws;
    gu32* ctl = (gu32*)(ws + WS_CTL);
    volatile LAS unsigned* MISC = (volatile LAS unsigned*)(lds + MISC_OFF);
    for (int u = tid; u < (LDS_BYTES - LDSCTL_OFF) / 4; u += NT) ((LAS unsigned*)(lds + LDSCTL_OFF))[u] = 0u;
    __syncthreads();
    XcdBarrier bar; bar.bar = (unsigned*)ctl + CW_BAR; bar.x = 0; bar.st = nullptr;
    if (N_LAUNCHES == 1) bar = xcd_barrier_post((unsigned*)ctl + CW_BAR, MISC + 8);
    const int lo = args.ph_lo, hi = args.ph_hi;
#define IN(k) (lo <= (k) && (k) < hi)
#define SEAM(k) do { if (IN(k) && IN((k) + 1)) xcd_barrier(bar); } while (0)

    const float* x = args.in[0]; const float* p_in = args.in[1]; const float* g_mix = args.in[2]; const float* w_in = args.in[3];
    const float* conv_w = args.in[4]; const float* conv_b = args.in[5]; const float* w_rg = args.in[6]; const float* b_rg = args.in[7];
    const float* w_ig = args.in[8]; const float* b_ig = args.in[9]; const float* lam = args.in[10]; const float* g_lru_out = args.in[11];
    const float* g_attn_out = args.in[12]; const float* w_out = args.in[13]; const float* rel_bias = args.in[14]; const float* g_ffn = args.in[15];
    const float* peer_wq = args.in[16]; const float* peer_k1 = args.in[17]; const float* peer_k2 = args.in[18]; const float* peer_u = args.in[19];
    const float* peer_v = args.in[20]; const float* g_ple = args.in[21]; const float* w_ple_gate = args.in[22]; const float* w_ple_proj = args.in[23];
    const float* g_final = args.in[24];
    float* out = args.out;
    bf16* Win_t = (bf16*)(ws + WS_WIN); bf16* Wout_t = (bf16*)(ws + WS_WOUT); bf16* Wcomb_t = (bf16*)(ws + WS_WCOMB); bf16* Wgate_t = (bf16*)(ws + WS_WGATE); bf16* Wproj_t = (bf16*)(ws + WS_WPROJ);
    float* ssq1 = (float*)(ws + WS_SSQ1); float* rinv2 = (float*)(ws + WS_RINV2); float* ssq3 = (float*)(ws + WS_SSQ3); float* lrus = (float*)(ws + WS_LRUS);
    int* ids = (int*)(ws + WS_IDS); float* gwt = (float*)(ws + WS_GW);
    bf16* A0 = (bf16*)(ws + WS_A0); bf16* A1 = (bf16*)(ws + WS_A1); bf16* Z = (bf16*)(ws + WS_Z);
    bf16* PU = (bf16*)(ws + WS_PU); bf16* PV = (bf16*)(ws + WS_PV); bf16* P16 = (bf16*)(ws + WS_P16);
    bf16* HL = A1; bf16* PC = A1 + (size_t)M * DLRU;
    _Float16* S16 = (_Float16*)(ws + WS_Z);
    bf16* Pout = (bf16*)(ws + WS_Z);

    if (IN(0)) {
        {
            LAS float* scr = (LAS float*)(lds + wave * 16384);
            constexpr int I_IN = (D / 64) * (DIN / 32), I_OUT = (D / 64) * (D / 32), I_GATE = I_OUT, I_PROJ = (PLE / 64) * (D / 32);
            constexpr int NITEMS = I_IN + I_OUT + I_GATE + I_PROJ;
            for (int it = gw; it < NITEMS; it += NGW) {
                int r = it;
                if (r < I_IN) { p0_transpose_item(w_in, D, DIN, Win_t, scr, r, lane, nullptr, ZC_Q, ZC_K); continue; } r -= I_IN;
                if (r < I_OUT) { p0_transpose_item(w_out, D, D, Wout_t, scr, r, lane, nullptr, 0, 0); continue; } r -= I_OUT;
                if (r < I_GATE) { p0_transpose_item(w_ple_gate, D, D, Wgate_t, scr, r, lane, g_ple, 0, 0); continue; } r -= I_GATE;
                p0_transpose_item(w_ple_proj, PLE, D, Wproj_t, scr, r, lane, nullptr, 0, 0);
            }
        }
        for (int m = gw; m < M; m += NGW) {
            const GAS f32x4* xr = (const GAS f32x4*)(x + (size_t)m * D) + lane;
            f32x4 v[4]; float s2 = 0.f;
#pragma unroll
            for (int j = 0; j < 4; ++j) { v[j] = xr[64 * j]; s2 += (v[j].x * v[j].x + v[j].y * v[j].y) + (v[j].z * v[j].z + v[j].w * v[j].w); }
            const float rinv = 1.0f / sqrtf(wave_sum(s2) * (1.f / D) + EPS);
            GAS unsigned long long* o8 = (GAS unsigned long long*)(A0 + (size_t)m * D) + lane;
#pragma unroll
            for (int j = 0; j < 4; ++j) { const f32x4 g = *((const GAS f32x4*)g_mix + lane + 64 * j);
                o8[64 * j] = (unsigned long long)pk2(v[j].x * rinv * g.x, v[j].y * rinv * g.y) | ((unsigned long long)pk2(v[j].z * rinv * g.z, v[j].w * rinv * g.w) << 32); }
        }
        {
            const size_t gt = (size_t)bx * NT + tid, GT = (size_t)G * NT;
            for (size_t i = gt; i < (size_t)M * PLE / 4; i += GT) { const f32x4 v = ((const GAS f32x4*)p_in)[i];
                ((GAS unsigned long long*)P16)[i] = (unsigned long long)pk2(v.x, v.y) | ((unsigned long long)pk2(v.z, v.w) << 32); }
            for (size_t i = gt; i < (size_t)16384 * D / 4; i += GT) { const f32x4 v = ((const GAS f32x4*)peer_u)[i]; const f32x4 g = ((const GAS f32x4*)g_ffn)[i & 255];
                ((GAS unsigned long long*)PU)[i] = (unsigned long long)pk2(v.x * g.x, v.y * g.y) | ((unsigned long long)pk2(v.z * g.z, v.w * g.w) << 32); }
            for (size_t i = gt; i < (size_t)16384 * D / 4; i += GT) { const f32x4 v = ((const GAS f32x4*)peer_v)[i];
                ((GAS unsigned long long*)PV)[i] = (unsigned long long)pk2(v.x, v.y) | ((unsigned long long)pk2(v.z, v.w) << 32); }
        }
        __syncthreads();
        {
            LAS float* ks = (LAS float*)lds;
            LAS float* wqs = (LAS float*)(lds + 65536);
            for (int it = bx; it < 256; it += G) {
                const int hh = it >> 4, d0 = (it & 15) * 64, half = hh & 1;
                const float* kh = half ? peer_k2 : peer_k1;
                for (int i = tid; i < 128 * 128; i += NT) ks[i] = kh[i];
                for (int i = tid; i < 64 * 128; i += NT) { const int dd = i >> 7, c = i & 127; wqs[dd * 129 + c] = peer_wq[(size_t)(d0 + dd) * 2048 + hh * 128 + c]; }
                __syncthreads();
                const int dd = lane, j0 = wave * 16;
                float acc[16];
#pragma unroll
                for (int jj = 0; jj < 16; ++jj) acc[jj] = 0.f;
                for (int c = 0; c < 128; ++c) { const float w = wqs[dd * 129 + c];
#pragma unroll
                    for (int jj = 0; jj < 16; ++jj) acc[jj] += w * ks[(j0 + jj) * 128 + c]; }
                const float gg = g_ffn[d0 + dd];
#pragma unroll
                for (int jj = 0; jj < 16; ++jj) Wcomb_t[(size_t)(hh * 128 + j0 + jj) * D + d0 + dd] = (bf16)f2bf(acc[jj] * gg);
                __syncthreads();
            }
        }
    }
    SEAM(0);

    if (IN(1)) {
        pg8::Gemm g{A0, Win_t, M, DIN, D}; pg8::StaticOrder S; S.init(M, DIN, G, bx);
        pg8::EpiBf16<0> E{Z, DIN, nullptr, 0, 0, 1.f};
        pg8::gemm_phase<pg8::EpiBf16<0>, pg8::StaticOrder, PG8_ALIGN, PG8_SP2>(lds, g, S, E);
    }
    SEAM(1);

    if (IN(2)) {
        for (int it = gw; it < NB * 8 * NCH; it += NGW) {
            const int b = it / (8 * NCH), g = (it / NCH) % 8, chunk = it % NCH, ch = g * 64 + lane;
            float wr[64], wi[64];
#pragma unroll
            for (int i = 0; i < 64; ++i) { wr[i] = w_rg[(size_t)(g * 64 + i) * 64 + lane]; wi[i] = w_ig[(size_t)(g * 64 + i) * 64 + lane]; }
            const float cw0 = conv_w[ch], cw1 = conv_w[512 + ch], cw2 = conv_w[1024 + ch], cw3 = conv_w[1536 + ch], cb = conv_b[ch];
            const float brg = b_rg[ch], big = b_ig[ch];
            const float sp = log1pf(expf(-lam[ch]));
            const int t0 = chunk * CH; const size_t rb = (size_t)b * SEQ;
            float xm3 = t0 >= 3 ? bf2f(Z[(rb + t0 - 3) * DIN + ZC_X + ch]) : 0.f;
            float xm2 = t0 >= 2 ? bf2f(Z[(rb + t0 - 2) * DIN + ZC_X + ch]) : 0.f;
            float xm1 = t0 >= 1 ? bf2f(Z[(rb + t0 - 1) * DIN + ZC_X + ch]) : 0.f;
            float h = 0.f, P = 1.f;
            for (int t = t0; t < t0 + CH; ++t) {
                const size_t row = rb + t;
                const float x0 = bf2f(Z[row * DIN + ZC_X + ch]);
                const float xc = cw0 * xm3 + cw1 * xm2 + cw2 * xm1 + cw3 * x0 + cb;
                float ar = brg, ai = big;
#pragma unroll
                for (int i = 0; i < 64; ++i) { const float xi = __int_as_float(__builtin_amdgcn_readlane(__float_as_int(xc), i)); ar += xi * wr[i]; ai += xi * wi[i]; }
                const float r = sigmoidf_(ar), ig = sigmoidf_(ai);
                const float log_a = -8.0f * r * sp;
                const float a = __expf(log_a);
                const float bt = sqrtf(-expm1f(2.0f * log_a)) * (ig * xc);
                h = a * h + bt; P = P * a;
                HL[row * DLRU + ch] = (bf16)f2bf(h); PC[row * DLRU + ch] = (bf16)f2bf(P);
                xm3 = xm2; xm2 = xm1; xm1 = x0;
            }
            lrus[((size_t)(b * NCH + chunk) * 2 + 0) * DLRU + ch] = P;
            lrus[((size_t)(b * NCH + chunk) * 2 + 1) * DLRU + ch] = h;
        }
        {
            LAS float* qs = (LAS float*)lds;
            LAS float* ps = (LAS float*)(lds + 2048);
            LAS float* red = (LAS float*)(lds + 2048 + 8 * 448 * 4);
            const int h = wave;
            for (int tok = bx; tok < M; tok += G) {
                const int t = tok & (SEQ - 1);
                qs[h * 64 + lane] = bf2f(Z[(size_t)tok * DIN + ZC_Q + h * 64 + lane]);
                LDS_WAIT(); asm volatile("" ::: "memory");
                float sc[7]; float mx = -3.0e38f;
#pragma unroll
                for (int rnd = 0; rnd < 7; ++rnd) {
                    const int pair = rnd * 64 + lane; float s = -3.0e38f;
                    if (pair < 387) { const int br = pair / 129, j = pair - br * 129, d = br == 0 ? 1 : (br == 1 ? 4 : 16);
                        if (t - j * d >= 0) { const GAS v4u* kr = (const GAS v4u*)(Z + (size_t)(tok - j * d) * DIN + ZC_K + h * 64); float dot = 0.f;
#pragma unroll
                            for (int c = 0; c < 8; ++c) { const v4u kv = kr[c]; const LAS float* q = qs + h * 64 + c * 8;
                                dot += q[0] * bflo(kv.x) + q[1] * bfhi(kv.x) + q[2] * bflo(kv.y) + q[3] * bfhi(kv.y) + q[4] * bflo(kv.z) + q[5] * bfhi(kv.z) + q[6] * bflo(kv.w) + q[7] * bfhi(kv.w); }
                            s = dot + rel_bias[t5_bucket(j * d) * NH + h]; } }
                    sc[rnd] = s; mx = fmaxf(mx, s);
                }
                mx = wave_max(mx); float l = 0.f;
#pragma unroll
                for (int rnd = 0; rnd < 7; ++rnd) { const float e = sc[rnd] > -1.0e38f ? __expf(sc[rnd] - mx) : 0.f; sc[rnd] = e; l += e; }
                l = wave_sum(l); const float il = 1.0f / l;
#pragma unroll
                for (int rnd = 0; rnd < 7; ++rnd) ps[h * 448 + rnd * 64 + lane] = sc[rnd] * il;
                LDS_WAIT(); asm volatile("" ::: "memory");
                float o = 0.f;
                for (int br = 0; br < 3; ++br) { const int d = br == 0 ? 1 : (br == 1 ? 4 : 16);
                    int jmax = t / d; if (jmax > 128) jmax = 128;
                    for (int j = 0; j <= jmax; ++j) o += ps[h * 448 + br * 129 + j] * bf2f(Z[(size_t)(tok - j * d) * DIN + ZC_V + h * 64 + lane]); }
                const float ss = wave_sum(o * o);
                __syncthreads();
                if (lane == 0) red[h] = ss;
                __syncthreads();
                float tot = 0.f;
#pragma unroll
                for (int w = 0; w < 8; ++w) tot += red[w];
                const float rinv = 1.0f / sqrtf(tot * (1.0f / 512.0f) + EPS);
                A0[(size_t)tok * D + 512 + h * 64 + lane] = (bf16)f2bf(o * rinv * g_attn_out[h * 64 + lane]);
            }
        }
    }
    SEAM(2);

    if (IN(3)) {
        LAS float* carry = (LAS float*)lds;
        for (int it = bx; it < NB * NCH; it += G) {
            const int b = it / NCH, chunk = it % NCH;
            { float hc = 0.f; const int ch = tid;
              for (int c = 0; c < chunk; ++c) { const float a = lrus[((size_t)(b * NCH + c) * 2 + 0) * DLRU + ch], bb = lrus[((size_t)(b * NCH + c) * 2 + 1) * DLRU + ch]; hc = a * hc + bb; }
              __syncthreads(); carry[ch] = hc; __syncthreads(); }
            for (int tt = wave; tt < CH; tt += NWAVES) {
                const size_t row = (size_t)b * SEQ + chunk * CH + tt;
                const v4u hl = *(const GAS v4u*)(HL + row * DLRU + lane * 8), pc = *(const GAS v4u*)(PC + row * DLRU + lane * 8), gt = *(const GAS v4u*)(Z + row * DIN + ZC_G + lane * 8);
                const unsigned hw[4] = {hl.x, hl.y, hl.z, hl.w}, pw[4] = {pc.x, pc.y, pc.z, pc.w}, gv[4] = {gt.x, gt.y, gt.z, gt.w};
                float y[8]; float ss = 0.f;
#pragma unroll
                for (int e = 0; e < 4; ++e) { const float c0 = carry[lane * 8 + 2 * e], c1 = carry[lane * 8 + 2 * e + 1];
                    const float h0 = bflo(hw[e]) + bflo(pw[e]) * c0, h1 = bfhi(hw[e]) + bfhi(pw[e]) * c1;
                    y[2 * e] = h0 * gelu_tanh(bflo(gv[e])); y[2 * e + 1] = h1 * gelu_tanh(bfhi(gv[e])); ss += y[2 * e] * y[2 * e] + y[2 * e + 1] * y[2 * e + 1]; }
                const float rinv = 1.0f / sqrtf(wave_sum(ss) * (1.0f / 512.0f) + EPS);
                const f32x4 g0 = *(const GAS f32x4*)(g_lru_out + lane * 8), g1 = *(const GAS f32x4*)(g_lru_out + lane * 8 + 4);
                v4u o; o.x = pk2(y[0] * rinv * g0.x, y[1] * rinv * g0.y); o.y = pk2(y[2] * rinv * g0.z, y[3] * rinv * g0.w); o.z = pk2(y[4] * rinv * g1.x, y[5] * rinv * g1.y); o.w = pk2(y[6] * rinv * g1.z, y[7] * rinv * g1.w);
                *(GAS v4u*)(A0 + row * D + lane * 8) = o;
            }
        }
    }
    SEAM(3);

    if (IN(4)) {
        pg8::Gemm g{A0, Wout_t, M, D, D}; pg8::StaticOrder S; S.init(M, D, G, bx);
        pg8::EpiResid E{x, out, A1, ssq1};
        pg8::gemm_phase<pg8::EpiResid, pg8::StaticOrder, PG8_ALIGN, PG8_SP2>(lds, g, S, E);
    }
    SEAM(4);

    if (IN(5)) {
        pg8::Gemm g{A1, Wcomb_t, M, 2048, D}; pg8::StaticOrder S; S.init(M, 2048, G, bx);
        pg8::EpiScore E{S16, ssq1, EPS};
        pg8::gemm_phase<pg8::EpiScore, pg8::StaticOrder, PG8_ALIGN, PG8_SP2>(lds, g, S, E);
    }
    SEAM(5);

    if (IN(6)) {
        for (int item = bx * NT + tid; item < M * NH; item += G * NT) {
            const int tok = item >> 3, h = item & 7;
            const GAS v4u* sp = (const GAS v4u*)(S16 + (size_t)tok * 2048 + h * 256);
            int t1[16], t2[16];
#pragma unroll
            for (int i = 0; i < 16; ++i) { t1[i] = (int)0x80000001; t2[i] = (int)0x80000001; }
#define ROUTE_INS(top, hbits, idx) do { const float f_ = (float)__builtin_bit_cast(_Float16, (unsigned short)(hbits)); \
        int b_ = __float_as_int(f_) | (idx); int x_ = b_ ^ ((b_ >> 31) & 0x7fffffff); \
        _Pragma("unroll") for (int i_ = 0; i_ < 16; ++i_) { const int hi_ = max(top[i_], x_); x_ = min(top[i_], x_); top[i_] = hi_; } } while (0)
            for (int c = 0; c < 16; ++c) { const v4u v = sp[c]; const unsigned w[4] = {v.x, v.y, v.z, v.w};
#pragma unroll
                for (int e = 0; e < 4; ++e) { ROUTE_INS(t1, w[e] & 0xffffu, c * 8 + 2 * e); ROUTE_INS(t1, w[e] >> 16, c * 8 + 2 * e + 1); } }
            for (int c = 0; c < 16; ++c) { const v4u v = sp[16 + c]; const unsigned w[4] = {v.x, v.y, v.z, v.w};
#pragma unroll
                for (int e = 0; e < 4; ++e) { ROUTE_INS(t2, w[e] & 0xffffu, c * 8 + 2 * e); ROUTE_INS(t2, w[e] >> 16, c * 8 + 2 * e + 1); } }
#undef ROUTE_INS
            float v1[16], v2[16]; int i1[16], i2[16];
#pragma unroll
            for (int i = 0; i < 16; ++i) { int b1 = t1[i] ^ ((t1[i] >> 31) & 0x7fffffff); i1[i] = b1 & 127; v1[i] = __int_as_float(b1 & ~127);
                                           int b2 = t2[i] ^ ((t2[i] >> 31) & 0x7fffffff); i2[i] = b2 & 127; v2[i] = __int_as_float(b2 & ~127); }
            float ts[16]; int ti[16];
#pragma unroll
            for (int i = 0; i < 16; ++i) { ts[i] = -3.0e38f; ti[i] = 0; }
#pragma unroll
            for (int a = 0; a < 16; ++a)
#pragma unroll
                for (int b = 0; b < 16; ++b) if ((a + 1) * (b + 1) <= 16) {
                    float s = v1[a] + v2[b]; int id = i1[a] * NKEY + i2[b];
#pragma unroll
                    for (int i = 0; i < 16; ++i) { const bool sw = s > ts[i]; const float ns = sw ? s : ts[i], xs = sw ? ts[i] : s; const int ni = sw ? id : ti[i], xi = sw ? ti[i] : id; ts[i] = ns; s = xs; ti[i] = ni; id = xi; }
                }
            float l = 0.f; float e[16];
#pragma unroll
            for (int i = 0; i < 16; ++i) { e[i] = __expf(ts[i] - ts[0]); l += e[i]; }
            const float il = 1.0f / l;
            GAS v4u* ip = (GAS v4u*)(ids + (size_t)item * 16); GAS f32x4* gp = (GAS f32x4*)(gwt + (size_t)item * 16);
#pragma unroll
            for (int q = 0; q < 4; ++q) { v4u iv; iv.x = (unsigned)ti[4 * q]; iv.y = (unsigned)ti[4 * q + 1]; iv.z = (unsigned)ti[4 * q + 2]; iv.w = (unsigned)ti[4 * q + 3]; ip[q] = iv;
                f32x4 gv; gv.x = e[4 * q] * il; gv.y = e[4 * q + 1] * il; gv.z = e[4 * q + 2] * il; gv.w = e[4 * q + 3] * il; gp[q] = gv; }
        }
    }
    SEAM(6);

    if (IN(7)) {
        {
            pg8::Gemm g{P16, Wproj_t, M, D, PLE}; pg8::StaticOrder S; S.init(M, D, G, bx);
            pg8::EpiBf16<0> E{Pout, D, nullptr, 0, 0, 1.f};
            pg8::gemm_phase<pg8::EpiBf16<0>, pg8::StaticOrder, PG8_ALIGN, PG8_SP2>(lds, g, S, E);
        }
        for (int tok = gw; tok < M; tok += NGW) {
            const float rinv1 = 1.0f / sqrtf(pg8::ssq16(ssq1 + (size_t)tok * 16) * (1.0f / 1024.0f) + EPS);
            float xv[16], acc[16];
            { const v4u a = *(const GAS v4u*)(A1 + (size_t)tok * D + lane * 16), b = *(const GAS v4u*)(A1 + (size_t)tok * D + lane * 16 + 8);
              const unsigned w[8] = {a.x, a.y, a.z, a.w, b.x, b.y, b.z, b.w};
#pragma unroll
              for (int e = 0; e < 8; ++e) { xv[2 * e] = bflo(w[e]); xv[2 * e + 1] = bfhi(w[e]); acc[2 * e] = 0.f; acc[2 * e + 1] = 0.f; } }
#pragma unroll 2
            for (int slot = 0; slot < NSLOT; ++slot) {
                const int id = __builtin_amdgcn_readfirstlane(ids[(size_t)tok * NSLOT + slot]);
                const float gsl = gwt[(size_t)tok * NSLOT + slot];
                const v4u ua = *(const GAS v4u*)(PU + (size_t)id * D + lane * 16), ub = *(const GAS v4u*)(PU + (size_t)id * D + lane * 16 + 8);
                const v4u va = *(const GAS v4u*)(PV + (size_t)id * D + lane * 16), vb = *(const GAS v4u*)(PV + (size_t)id * D + lane * 16 + 8);
                const unsigned uw[8] = {ua.x, ua.y, ua.z, ua.w, ub.x, ub.y, ub.z, ub.w}, vw[8] = {va.x, va.y, va.z, va.w, vb.x, vb.y, vb.z, vb.w};
                float dot = 0.f;
#pragma unroll
                for (int e = 0; e < 8; ++e) dot += xv[2 * e] * bflo(uw[e]) + xv[2 * e + 1] * bfhi(uw[e]);
                dot = wave_sum(dot);
                const float act = gelu_tanh(dot * rinv1) * gsl;
#pragma unroll
                for (int e = 0; e < 8; ++e) { acc[2 * e] += act * bflo(vw[e]); acc[2 * e + 1] += act * bfhi(vw[e]); }
            }
            GAS f32x4* hp = (GAS f32x4*)(out + (size_t)tok * D + lane * 16); float ss = 0.f; float hv[16];
#pragma unroll
            for (int q = 0; q < 4; ++q) { f32x4 hh = hp[q]; hh.x += acc[4 * q]; hh.y += acc[4 * q + 1]; hh.z += acc[4 * q + 2]; hh.w += acc[4 * q + 3]; hp[q] = hh;
                hv[4 * q] = hh.x; hv[4 * q + 1] = hh.y; hv[4 * q + 2] = hh.z; hv[4 * q + 3] = hh.w; ss += (hh.x * hh.x + hh.y * hh.y) + (hh.z * hh.z + hh.w * hh.w); }
            ss = wave_sum(ss);
            if (lane == 0) rinv2[tok] = 1.0f / sqrtf(ss * (1.0f / 1024.0f) + EPS);
            v4u o0, o1; o0.x = pk2(hv[0], hv[1]); o0.y = pk2(hv[2], hv[3]); o0.z = pk2(hv[4], hv[5]); o0.w = pk2(hv[6], hv[7]);
            o1.x = pk2(hv[8], hv[9]); o1.y = pk2(hv[10], hv[11]); o1.z = pk2(hv[12], hv[13]); o1.w = pk2(hv[14], hv[15]);
            *(GAS v4u*)(A0 + (size_t)tok * D + lane * 16) = o0; *(GAS v4u*)(A0 + (size_t)tok * D + lane * 16 + 8) = o1;
        }
    }
    SEAM(7);

    if (IN(8)) {
        pg8::Gemm g{A0, Wgate_t, M, D, D}; pg8::StaticOrder S; S.init(M, D, G, bx);
        pg8::EpiPle E{out, Pout, rinv2, ssq3};
        pg8::gemm_phase<pg8::EpiPle, pg8::StaticOrder, PG8_ALIGN, PG8_SP2>(lds, g, S, E);
    }
    SEAM(8);

    if (IN(9)) {
        for (int m = gw; m < M; m += NGW) {
            const float rinv = 1.0f / sqrtf(pg8::ssq16(ssq3 + (size_t)m * 16) * (1.0f / 1024.0f) + EPS);
            GAS f32x4* op = (GAS f32x4*)(out + (size_t)m * D) + lane;
#pragma unroll
            for (int j = 0; j < 4; ++j) { f32x4 v = op[64 * j]; const f32x4 g = *((const GAS f32x4*)g_final + lane + 64 * j);
                v.x *= rinv * g.x; v.y *= rinv * g.y; v.z *= rinv * g.z; v.w *= rinv * g.w; op[64 * j] = v; }
        }
    }
#undef IN
#undef SEAM
}

extern "C" void kernel_launch(void* const* d_in, const int* in_sizes, int n_in, void* d_out, int out_size, void* d_ws, size_t ws_size, hipStream_t stream) {
    static int grid = 0;
    if (grid == 0) {
        if (n_in != 25 || in_sizes[0] != M * D || out_size != M * D || ws_size < WS_END) { fprintf(stderr, "kernel_launch: unexpected shapes (n_in %d, in0 %d, out %d, ws %zu); nothing launched\n", n_in, n_in > 0 ? in_sizes[0] : -1, out_size, ws_size); grid = -1; return; }
        int dev = 0, cus = 0, per_cu = 0;
        if (hipGetDevice(&dev) != hipSuccess || hipDeviceGetAttribute(&cus, hipDeviceAttributeMultiprocessorCount, dev) != hipSuccess) { grid = -1; return; }
        if (hipFuncSetAttribute((const void*)hybrid_fwd, hipFuncAttributeMaxDynamicSharedMemorySize, LDS_BYTES) != hipSuccess) { fprintf(stderr, "kernel_launch: hipFuncSetAttribute failed\n"); grid = -1; return; }
        if (hipOccupancyMaxActiveBlocksPerMultiprocessor(&per_cu, (const void*)hybrid_fwd, NT, LDS_BYTES) != hipSuccess || per_cu < 1)
            fprintf(stderr, "kernel_launch: note: occupancy query reports %d workgroups per CU\n", per_cu);
        (void)hipGetLastError();
        grid = cus;
    }
    if (grid < 0) return;
    if (hipMemsetAsync((char*)d_ws + WS_CTL, 0, CTL_ZERO_BYTES, stream) != hipSuccess) return;
    Args a{};
    for (int i = 0; i < 25; ++i) a.in[i] = (const float*)d_in[i];
    a.out = (float*)d_out; a.ws = (unsigned char*)d_ws;
    if (N_LAUNCHES == 1) { a.ph_lo = 0; a.ph_hi = NPHASE; hipLaunchKernelGGL(hybrid_fwd, dim3(grid), dim3(NT), LDS_BYTES, stream, a); }
    else for (int li = 0; li < NPHASE; ++li) { a.ph_lo = li; a.ph_hi = li + 1; hipLaunchKernelGGL(hybrid_fwd, dim3(grid), dim3(NT), LDS_BYTES, stream, a); }
}
```

```cpp
#include <hip/hip_runtime.h>
#include <cstdio>
#include <cstdint>
namespace pg8 {
#define PG8_LAS __attribute__((address_space(3)))
typedef unsigned short bf16_t;
typedef short bf16x8 __attribute__((ext_vector_type(8)));
typedef float f32x4 __attribute__((ext_vector_type(4)));
typedef unsigned u32x4 __attribute__((ext_vector_type(4)));
constexpr int BM = 256, BK = 64, HALF = 128, HTB = HALF * BK * 2  , STAGE_BYTES = 8 * HTB, NXCD = 8, WGM = 8;

__host__ __device__ __forceinline__ int lds_byte(int r, int c) { const int st = (r >> 4) * 2 + (c >> 5), rr = r & 15, cc = c & 31, ob = rr * 64 + cc * 2; return st * 1024 + (ob ^ (((ob >> 9) & 1) << 5)); }
__host__ __device__ __forceinline__ void stage_rc(int b, int& R, int& C) { const int st = b / 1024, sb = b % 1024, swz = sb ^ (((sb >> 9) & 1) << 5); R = (st >> 1) * 16 + swz / 64; C = (st & 1) * 32 + (swz % 64) / 2; }
__host__ __device__ __forceinline__ int perm32(int rho) { const int n = rho >> 4, i = rho & 15; return 8 * (i >> 2) + 4 * n + (i & 3); }

struct Unit { int pm, pn; };
struct Gemm { const bf16_t* A; const bf16_t* Bt; int M, N, K; };

struct StaticOrder {
    int nM, nN, nwg, G, c;
    __host__ __device__ void init(int M, int N, int G_, int c_) { nM = M / BM; nN = N / BM; nwg = nM * nN; G = G_; c = c_; }
    __host__ __device__ bool next(int i, Unit& u) const {
        const long L = (long)i * G + c; if (L >= nwg) return false;
        int wgid = (int)L; { const int q = nwg / NXCD, r = nwg % NXCD, xcd = wgid % NXCD, off = wgid / NXCD; wgid = (xcd < r ? xcd * (q + 1) : r * (q + 1) + (xcd - r) * q) + off; }
        const int nig = WGM * nN, gid = wgid / nig, fm = gid * WGM, gsz = (nM - fm) < WGM ? (nM - fm) : WGM;
        u.pm = fm + ((wgid % nig) % gsz); u.pn = (wgid % nig) / gsz; return true;
    }
    __device__ __forceinline__ void a_ready(const Unit&) const {}
    __device__ __forceinline__ void done(const Unit&) const {}
};

__device__ __forceinline__ unsigned cvt_pk_bf16(float lo, float hi) { unsigned r; asm volatile("v_cvt_pk_bf16_f32 %0, %1, %2" : "=v"(r) : "v"(lo), "v"(hi)); return r; }
typedef float f32x2 __attribute__((ext_vector_type(2)));
__device__ __forceinline__ f32x2 gelu_pk(f32x2 v) {
    const f32x2 av = __builtin_elementwise_abs(v), d = av * 0.2316418882f + 1.0f;
    f32x2 t; t.x = __builtin_amdgcn_rcpf(d.x); t.y = __builtin_amdgcn_rcpf(d.y);
    f32x2 q = t * 0.5307027145f + (-0.7265760135f); q = q * t + 0.7107068705f; q = q * t + (-0.142248368f); q = q * t + 0.127414796f; q = q * t;
    const f32x2 s = (v * v) * (-0.72134752044f);
    f32x2 e; e.x = __builtin_amdgcn_exp2f(s.x); e.y = __builtin_amdgcn_exp2f(s.y);
    const f32x2 m = v * (q * e), r = v - m;
    f32x2 o; o.x = v.x < 0.f ? m.x : r.x; o.y = v.y < 0.f ? m.y : r.y; return o;
}

template <int ACT  > struct EpiBf16 {
    static constexpr bool PERM = true, AFTER_DRAIN = false; static_assert(ACT == 0 || ACT == 1, "EpiBf16: ACT is 0 (none) or 1 (gelu_pk)");
    bf16_t* O; int ldc; const float* bias; int split_cols; size_t split_stride; float scale0;
    __device__ __forceinline__ void operator()(const f32x4 (&acc)[2][2][4][2], const Unit& u, int wr, int wc, int fr, int fq) const {
        const int row0 = u.pm * BM + wr * 64 + fr; int colt = u.pn * BM; bf16_t* base = O;
        float sc = 1.f; if (split_cols) { const int t = colt / split_cols; base += (size_t)t * split_stride; colt -= t * split_cols; if (t == 0) sc = scale0; }
        const int col0 = colt + wc * 32 + 8 * fq, bcol0 = u.pn * BM + wc * 32 + 8 * fq;
        f32x4 bv[2][2];
#pragma unroll
        for (int bj = 0; bj < 2; ++bj)
#pragma unroll
            for (int n = 0; n < 2; ++n) bv[bj][n] = bias ? *(const f32x4*)(bias + bcol0 + bj * HALF + 4 * n) : (f32x4){0.f, 0.f, 0.f, 0.f};
#pragma unroll
        for (int ai = 0; ai < 2; ++ai)
#pragma unroll
            for (int m = 0; m < 4; ++m) { bf16_t* rowp = base + (size_t)(row0 + ai * HALF + m * 16) * ldc + col0;
#pragma unroll
                for (int bj = 0; bj < 2; ++bj) { f32x4 v0 = acc[ai][bj][m][0] + bv[bj][0], v1 = acc[ai][bj][m][1] + bv[bj][1];
                    if (ACT == 1) { f32x2 a = gelu_pk((f32x2){v0[0], v0[1]}), b = gelu_pk((f32x2){v0[2], v0[3]}), c = gelu_pk((f32x2){v1[0], v1[1]}), d = gelu_pk((f32x2){v1[2], v1[3]});
                        v0 = (f32x4){a.x, a.y, b.x, b.y}; v1 = (f32x4){c.x, c.y, d.x, d.y}; }
                    v0 = v0 * sc; v1 = v1 * sc; u32x4 w; w.x = cvt_pk_bf16(v0[0], v0[1]); w.y = cvt_pk_bf16(v0[2], v0[3]); w.z = cvt_pk_bf16(v1[0], v1[1]); w.w = cvt_pk_bf16(v1[2], v1[3]);
                    *(u32x4*)(rowp + bj * HALF) = w; } }
    }
};
template <class Epi, class Sched, bool ALIGN_EPI = false, bool SP2 = false>
__device__ __forceinline__ void gemm_phase(PG8_LAS unsigned char* lds, const Gemm g, const Sched& S, const Epi& E) {
    const int tid = threadIdx.x, wid = __builtin_amdgcn_readfirstlane(tid >> 6), lane = tid & 63, wr = wid >> 2, wc = wid & 3, fr = lane & 15, fq = lane >> 4;
    const int K = g.K, nt = K / BK;
    unsigned voffA[2], voffB[2];
#pragma unroll
    for (int i = 0; i < 2; ++i) { int R, C; stage_rc(tid * 16 + i * 8192, R, C); const int Rb = Epi::PERM ? ((R & ~31) + perm32(R & 31)) : R;
        voffA[i] = (unsigned)(R * K + C) * 2u; voffB[i] = (unsigned)(Rb * K + C) * 2u; }
    const size_t kstep = (size_t)(BK * 2);
    const size_t hstep = (size_t)HALF * K * 2;
    const size_t tstep = 2 * hstep;
    const unsigned ldsw = (unsigned)wid * 1024u;
    const int aoff = lds_byte(wr * 64 + fr, fq * 8), boff = lds_byte(wc * 32 + fr, fq * 8);
#define PG8_SA(b, h) (((b) * 2 + (h)) * HTB)
#define PG8_SB(b, h) ((4 + (b) * 2 + (h)) * HTB)
#define PG8_STAGE(bufoff, gbase, voff) do { _Pragma("unroll") for (int _i = 0; _i < 2; ++_i) \
        __builtin_amdgcn_global_load_lds((const unsigned*)((const char*)(gbase) + (voff)[_i]), (PG8_LAS unsigned*)(lds + (bufoff) + ldsw + _i * 8192), 16, 0, 0); } while (0)
#define PG8_LDA(dst, b, h) do { _Pragma("unroll") for (int m = 0; m < 4; ++m) _Pragma("unroll") for (int k = 0; k < 2; ++k) dst[m][k] = *(const PG8_LAS bf16x8*)(lds + PG8_SA(b, h) + aoff + m * 2048 + k * 1024); } while (0)
#define PG8_LDB(dst, b, h) do { _Pragma("unroll") for (int n = 0; n < 2; ++n) _Pragma("unroll") for (int k = 0; k < 2; ++k) dst[n][k] = *(const PG8_LAS bf16x8*)(lds + PG8_SB(b, h) + boff + n * 2048 + k * 1024); } while (0)
#define PG8_MMA(ai, bj, At, Bt) do { __builtin_amdgcn_s_setprio(1); _Pragma("unroll") for (int m = 0; m < 4; ++m) _Pragma("unroll") for (int n = 0; n < 2; ++n) _Pragma("unroll") for (int k = 0; k < 2; ++k) \
        acc[ai][bj][m][n] = __builtin_amdgcn_mfma_f32_16x16x32_bf16(Bt[n][k], At[m][k], acc[ai][bj][m][n], 0, 0, 0); __builtin_amdgcn_s_setprio(0); } while (0)
#define PG8_WAIT_V(n) asm volatile("s_waitcnt vmcnt(" #n ")" ::: "memory")
#define PG8_WAIT_L(n) asm volatile("s_waitcnt lgkmcnt(" #n ")" ::: "memory")
#define PG8_BAR __builtin_amdgcn_s_barrier()
#define PG8_SCHED __builtin_amdgcn_sched_barrier(0)
    Unit cur, nxt; int ui = 0;
    if (!S.next(0, cur)) return;
    f32x4 acc[2][2][4][2];
#pragma unroll
    for (int a = 0; a < 2; ++a)
#pragma unroll
        for (int b = 0; b < 2; ++b)
#pragma unroll
            for (int m = 0; m < 4; ++m)
#pragma unroll
                for (int n = 0; n < 2; ++n) acc[a][b][m][n] = (f32x4){0.f, 0.f, 0.f, 0.f};
    bf16x8 At[4][2], B0[2][2], B1[2][2];
    const char* cA = (const char*)g.A + (size_t)cur.pm * tstep; const char* cB = (const char*)g.Bt + (size_t)cur.pn * tstep;
    S.a_ready(cur);
    if constexpr (SP2) {
        PG8_STAGE(PG8_SB(0, 0), cB, voffB); PG8_STAGE(PG8_SB(0, 1), cB + hstep, voffB); PG8_STAGE(PG8_SA(0, 0), cA, voffA); PG8_STAGE(PG8_SA(0, 1), cA + hstep, voffA);
        if (wr == 1) PG8_BAR;
        PG8_WAIT_V(2); PG8_BAR;
        PG8_STAGE(PG8_SB(1, 0), cB + kstep, voffB); PG8_STAGE(PG8_SA(1, 0), cA + kstep, voffA); PG8_STAGE(PG8_SB(1, 1), cB + hstep + kstep, voffB);
        PG8_WAIT_V(6); PG8_BAR;
    } else {
        PG8_STAGE(PG8_SB(0, 0), cB, voffB); PG8_STAGE(PG8_SA(0, 0), cA, voffA); PG8_STAGE(PG8_SB(0, 1), cB + hstep, voffB); PG8_STAGE(PG8_SA(0, 1), cA + hstep, voffA);
        if (wr == 1) PG8_BAR;
        PG8_WAIT_V(4); PG8_BAR;
        PG8_STAGE(PG8_SB(1, 0), cB + kstep, voffB); PG8_STAGE(PG8_SA(1, 0), cA + kstep, voffA); PG8_STAGE(PG8_SB(1, 1), cB + hstep + kstep, voffB);
        PG8_WAIT_V(6); PG8_BAR;
    }
    for (;;) {
        const bool has_next = S.next(ui + 1, nxt);
        const char* nA = has_next ? (const char*)g.A + (size_t)nxt.pm * tstep : cA; const char* nB = has_next ? (const char*)g.Bt + (size_t)nxt.pn * tstep : cB;
        for (int t = 0; t < nt; t += 2) {
            const bool last = (t == nt - 2);
            const char* a1 = cA + (size_t)(t + 1) * kstep;
            const char* a2 = last ? nA : cA + (size_t)(t + 2) * kstep; const char* b2 = last ? nB : cB + (size_t)(t + 2) * kstep;
            const char* a3 = a2 + kstep; const char* b3 = b2 + kstep;
            if (last && has_next) S.a_ready(nxt);
            if constexpr (SP2) {
            PG8_LDB(B0, 0, 0); PG8_LDB(B1, 0, 1); PG8_SCHED; PG8_LDA(At, 0, 0); PG8_STAGE(PG8_SA(1, 1), a1 + hstep, voffA);
            PG8_WAIT_V(8); PG8_WAIT_L(0); PG8_BAR; PG8_MMA(0, 0, At, B0); PG8_MMA(0, 1, At, B1); PG8_BAR; PG8_SCHED;
            PG8_LDA(At, 0, 1); PG8_STAGE(PG8_SB(0, 0), b2, voffB); PG8_STAGE(PG8_SB(0, 1), b2 + hstep, voffB); PG8_STAGE(PG8_SA(0, 0), a2, voffA);
            PG8_WAIT_V(8); PG8_WAIT_L(0); PG8_BAR; PG8_MMA(1, 0, At, B0); PG8_MMA(1, 1, At, B1); PG8_BAR; PG8_SCHED;
            PG8_LDB(B0, 1, 0); PG8_LDB(B1, 1, 1); PG8_SCHED; PG8_LDA(At, 1, 0); PG8_STAGE(PG8_SA(0, 1), a2 + hstep, voffA);
            PG8_WAIT_V(8); PG8_WAIT_L(0); PG8_BAR; PG8_MMA(0, 0, At, B0); PG8_MMA(0, 1, At, B1); PG8_BAR; PG8_SCHED;
            PG8_LDA(At, 1, 1); PG8_STAGE(PG8_SB(1, 0), b3, voffB); PG8_STAGE(PG8_SB(1, 1), b3 + hstep, voffB); PG8_STAGE(PG8_SA(1, 0), a3, voffA);
            PG8_WAIT_V(8); PG8_WAIT_L(0); PG8_BAR; PG8_MMA(1, 0, At, B0); PG8_MMA(1, 1, At, B1); PG8_BAR; PG8_SCHED;
            } else {
            PG8_LDB(B0, 0, 0); PG8_SCHED; PG8_LDA(At, 0, 0); PG8_STAGE(PG8_SA(1, 1), a1 + hstep, voffA);
            PG8_WAIT_L(8); PG8_BAR; PG8_WAIT_L(0); PG8_MMA(0, 0, At, B0); PG8_BAR; PG8_SCHED;
            PG8_LDB(B1, 0, 1); PG8_STAGE(PG8_SB(0, 0), b2, voffB);
            PG8_BAR; PG8_WAIT_L(0); PG8_MMA(0, 1, At, B1); PG8_BAR;
            PG8_LDA(At, 0, 1); PG8_STAGE(PG8_SA(0, 0), a2, voffA);
            PG8_BAR; PG8_WAIT_L(0); PG8_MMA(1, 0, At, B0); PG8_BAR; PG8_SCHED;
            PG8_STAGE(PG8_SB(0, 1), b2 + hstep, voffB);
            PG8_WAIT_V(6); PG8_BAR; PG8_MMA(1, 1, At, B1); PG8_BAR;
            PG8_LDB(B0, 1, 0); PG8_SCHED; PG8_LDA(At, 1, 0); PG8_STAGE(PG8_SA(0, 1), a2 + hstep, voffA);
            PG8_WAIT_L(8); PG8_BAR; PG8_WAIT_L(0); PG8_MMA(0, 0, At, B0); PG8_BAR; PG8_SCHED;
            PG8_LDB(B1, 1, 1); PG8_STAGE(PG8_SB(1, 0), b3, voffB);
            PG8_BAR; PG8_WAIT_L(0); PG8_MMA(0, 1, At, B1); PG8_BAR;
            PG8_LDA(At, 1, 1); PG8_STAGE(PG8_SA(1, 0), a3, voffA);
            PG8_BAR; PG8_WAIT_L(0); PG8_MMA(1, 0, At, B0); PG8_BAR; PG8_SCHED;
            PG8_STAGE(PG8_SB(1, 1), b3 + hstep, voffB);
            PG8_WAIT_V(6); PG8_BAR; PG8_MMA(1, 1, At, B1); PG8_BAR;
            }
        }
        if constexpr (ALIGN_EPI) { if (wr == 0) PG8_BAR; }
        if constexpr (!Epi::AFTER_DRAIN) { E(acc, cur, wr, wc, fr, fq); S.done(cur); }
        if (!has_next) break;
#pragma unroll
        for (int a = 0; a < 2; ++a)
#pragma unroll
            for (int b = 0; b < 2; ++b)
#pragma unroll
                for (int m = 0; m < 4; ++m)
#pragma unroll
                    for (int n = 0; n < 2; ++n) acc[a][b][m][n] = (f32x4){0.f, 0.f, 0.f, 0.f};
        cur = nxt; cA = nA; cB = nB; ++ui;
        if constexpr (ALIGN_EPI) { if (wr == 1) PG8_BAR; }
    }
    PG8_WAIT_V(0);
    if constexpr (!ALIGN_EPI) { if (wr == 0) PG8_BAR; }
    PG8_BAR;
    if constexpr (Epi::AFTER_DRAIN) { E.fused(acc, cur, wr, wc, fr, fq, lds, wid, lane); S.done(cur); }
#undef PG8_SA
#undef PG8_SB
#undef PG8_STAGE
#undef PG8_LDA
#undef PG8_LDB
#undef PG8_MMA
#undef PG8_WAIT_V
#undef PG8_WAIT_L
#undef PG8_BAR
#undef PG8_SCHED
}
}
namespace pg8 {
typedef unsigned u32x2 __attribute__((ext_vector_type(2)));
__device__ __forceinline__ float ssq16(const float* p) {
    const f32x4 a = *(const f32x4*)p, b = *(const f32x4*)(p + 4), c = *(const f32x4*)(p + 8), d = *(const f32x4*)(p + 12);
    return ((a[0] + a[1]) + (a[2] + a[3])) + ((b[0] + b[1]) + (b[2] + b[3])) + ((c[0] + c[1]) + (c[2] + c[3])) + ((d[0] + d[1]) + (d[2] + d[3]));
}
struct EpiResid {
    static constexpr bool PERM = false, AFTER_DRAIN = false;
    const float* resid; float* out; bf16_t* ob; float* ssq;
    __device__ __forceinline__ void operator()(const f32x4 (&acc)[2][2][4][2], const Unit& u, int wr, int wc, int fr, int fq) const {
        const int row0 = u.pm * BM + wr * 64 + fr, col0 = u.pn * BM + wc * 32 + 4 * fq;
#pragma unroll
        for (int ai = 0; ai < 2; ++ai)
#pragma unroll
            for (int m = 0; m < 4; ++m) { const int row = row0 + ai * HALF + m * 16; const size_t off = (size_t)row * 1024 + col0; float ss = 0.f;
#pragma unroll
                for (int bj = 0; bj < 2; ++bj)
#pragma unroll
                    for (int n = 0; n < 2; ++n) { const int co = bj * HALF + n * 16; const f32x4 v = acc[ai][bj][m][n] + *(const f32x4*)(resid + off + co);
                        ss += (v[0] * v[0] + v[1] * v[1]) + (v[2] * v[2] + v[3] * v[3]);
                        u32x2 w; w.x = cvt_pk_bf16(v[0], v[1]); w.y = cvt_pk_bf16(v[2], v[3]); *(u32x2*)(ob + off + co) = w; }
                ss += __shfl_xor(ss, 16); ss += __shfl_xor(ss, 32);
                if (fq == 0) ssq[(size_t)row * 16 + u.pn * 4 + wc] = ss; }
    }
};
struct EpiScore {
    static constexpr bool PERM = true, AFTER_DRAIN = false;
    _Float16* S; const float* ssq; float eps;
    __device__ __forceinline__ void operator()(const f32x4 (&acc)[2][2][4][2], const Unit& u, int wr, int wc, int fr, int fq) const {
        typedef _Float16 h2 __attribute__((ext_vector_type(2)));
        const int row0 = u.pm * BM + wr * 64 + fr, col0 = u.pn * BM + wc * 32 + 8 * fq;
#pragma unroll
        for (int ai = 0; ai < 2; ++ai)
#pragma unroll
            for (int m = 0; m < 4; ++m) { const int row = row0 + ai * HALF + m * 16;
                const float rinv = __builtin_amdgcn_rsqf(ssq16(ssq + (size_t)row * 16) * (1.0f / 1024.0f) + eps);
                _Float16* rowp = S + (size_t)row * 2048 + col0;
#pragma unroll
                for (int bj = 0; bj < 2; ++bj) { const f32x4 v0 = acc[ai][bj][m][0] * rinv, v1 = acc[ai][bj][m][1] * rinv;
                    u32x4 w; h2 t;
                    t.x = (_Float16)v0[0]; t.y = (_Float16)v0[1]; w.x = __builtin_bit_cast(unsigned, t);
                    t.x = (_Float16)v0[2]; t.y = (_Float16)v0[3]; w.y = __builtin_bit_cast(unsigned, t);
                    t.x = (_Float16)v1[0]; t.y = (_Float16)v1[1]; w.z = __builtin_bit_cast(unsigned, t);
                    t.x = (_Float16)v1[2]; t.y = (_Float16)v1[3]; w.w = __builtin_bit_cast(unsigned, t);
                    *(u32x4*)(rowp + bj * HALF) = w; } }
    }
};
struct EpiPle {
    static constexpr bool PERM = false, AFTER_DRAIN = false;
    float* io; const bf16_t* hin; const bf16_t* P; const float* ssq_in; float* ssq; float eps;
    __device__ __forceinline__ void operator()(const f32x4 (&acc)[2][2][4][2], const Unit& u, int wr, int wc, int fr, int fq) const {
        const int row0 = u.pm * BM + wr * 64 + fr, col0 = u.pn * BM + wc * 32 + 4 * fq;
#pragma unroll
        for (int ai = 0; ai < 2; ++ai)
#pragma unroll
            for (int m = 0; m < 4; ++m) { const int row = row0 + ai * HALF + m * 16; const size_t off = (size_t)row * 1024 + col0; float ss = 0.f; const f32x4 qa = *(const f32x4*)(ssq_in + (size_t)row * 8), qb = *(const f32x4*)(ssq_in + (size_t)row * 8 + 4); const float ri = __builtin_amdgcn_rsqf((((qa[0] + qa[1]) + (qa[2] + qa[3])) + ((qb[0] + qb[1]) + (qb[2] + qb[3]))) * (1.0f / 1024.0f) + eps);
#pragma unroll
                for (int bj = 0; bj < 2; ++bj)
#pragma unroll
                    for (int n = 0; n < 2; ++n) { const int co = bj * HALF + n * 16; const f32x4 a = acc[ai][bj][m][n] * ri; const u32x2 hw = *(const u32x2*)(hin + off + co); f32x4 h; h[0] = __uint_as_float(hw.x << 16); h[1] = __uint_as_float(hw.x & 0xffff0000u); h[2] = __uint_as_float(hw.y << 16); h[3] = __uint_as_float(hw.y & 0xffff0000u);
                        const u32x2 pw = *(const u32x2*)(P + off + co);
                        f32x4 pv; pv[0] = __uint_as_float(pw.x << 16); pv[1] = __uint_as_float(pw.x & 0xffff0000u); pv[2] = __uint_as_float(pw.y << 16); pv[3] = __uint_as_float(pw.y & 0xffff0000u);
                        f32x4 v;
#pragma unroll
                        for (int j = 0; j < 4; ++j) v[j] = h[j] + pv[j] / (1.0f + __expf(-a[j]));
                        *(f32x4*)(io + off + co) = v; ss += (v[0] * v[0] + v[1] * v[1]) + (v[2] * v[2] + v[3] * v[3]); }
                ss += __shfl_xor(ss, 16); ss += __shfl_xor(ss, 32);
                if (fq == 0) ssq[(size_t)row * 16 + u.pn * 4 + wc] = ss; }
    }
};
}
#ifndef PG8_SP2
#define PG8_SP2 true
#endif
#ifndef PG8_ALIGN
#define PG8_ALIGN true
#endif
#define GAS __attribute__((address_space(1)))
#define LAS __attribute__((address_space(3)))
typedef unsigned short bf16;
typedef unsigned v4u __attribute__((ext_vector_type(4)));
typedef float f32x4 __attribute__((ext_vector_type(4)));
typedef short bf16x8 __attribute__((ext_vector_type(8)));
typedef GAS unsigned gu32;
typedef GAS unsigned long long gu64;
#define RLX_AGENT __ATOMIC_RELAXED, __HIP_MEMORY_SCOPE_AGENT
#define LDS_WAIT() asm volatile("s_waitcnt lgkmcnt(0)" ::: "memory")
#define VM_WAIT() asm volatile("s_waitcnt vmcnt(0)" ::: "memory")
__device__ __forceinline__ unsigned long long rt() { return __builtin_amdgcn_s_memrealtime(); }
__device__ __forceinline__ unsigned f2bf(float f) { unsigned u = __builtin_bit_cast(unsigned, f); return (u + 0x7fffu + ((u >> 16) & 1u)) >> 16; }
__device__ __forceinline__ unsigned pk2(float lo, float hi) { return f2bf(lo) | (f2bf(hi) << 16); }

#define XB_TMO      128
#define XB_XCNT(j)  (256  + 64 * (j))
#define XB_XSUB(j)  (1280 + 64 * (j))
#define XB_XGEN(j)  (2304 + 64 * (j))
#define XB_TOP      3328
#define XB_TOPGEN   3392
#define XCD_BAR_WORDS 3456
#define XB_SPIN_CAP (1u << 18)

__device__ __forceinline__ unsigned xb_ld(unsigned* p)              { return __hip_atomic_load(p, __ATOMIC_RELAXED, __HIP_MEMORY_SCOPE_AGENT); }
__device__ __forceinline__ unsigned xb_add(unsigned* p, unsigned v) { return __hip_atomic_fetch_add(p, v, __ATOMIC_RELAXED, __HIP_MEMORY_SCOPE_AGENT); }
__device__ __forceinline__ unsigned xb_xcc_id() { return (unsigned)__builtin_amdgcn_s_getreg((3 << 11) | 20) & 0xFu; }
#define XB_SPIN(cond, bar) do { unsigned _sp = 0; while (cond) { __builtin_amdgcn_s_sleep(1); \
    if ((++_sp & 255u) == 0u) { if (xb_ld(&(bar)[XB_TMO])) break; if (_sp > XB_SPIN_CAP) { atomicAdd(&(bar)[XB_TMO], 1u); break; } } } } while (0)

struct XcdBarrier {
    unsigned* bar; unsigned x;
    volatile LAS unsigned* st;
};

__device__ __forceinline__ XcdBarrier xcd_barrier_post(unsigned* bar, volatile LAS unsigned* st) {
    XcdBarrier b; b.bar = bar; b.x = xb_xcc_id(); b.st = st;
    if (threadIdx.x == 0) (void)xb_add(&bar[XB_XCNT(b.x)], 1u);
    return b;
}
__device__ __forceinline__ void xcd_barrier_complete(unsigned* bar, unsigned x, unsigned& nloc, unsigned& nx) {
    const unsigned G = gridDim.x * gridDim.y * gridDim.z;
    unsigned sum, cnt, mine, sp = 0u;
    for (;;) {
        sum = 0u; cnt = 0u; mine = 0u;
#pragma unroll
        for (unsigned j = 0; j < 16; ++j) { const unsigned c = xb_ld(&bar[XB_XCNT(j)]); sum += c; cnt += (c > 0u) ? 1u : 0u; mine = (j == x) ? c : mine; }
        if (sum == G) break;
        __builtin_amdgcn_s_sleep(1);
        if ((++sp & 255u) == 0u) { if (xb_ld(&bar[XB_TMO])) break; if (sp > XB_SPIN_CAP) { atomicAdd(&bar[XB_TMO], 1u); break; } }
    }
    nloc = mine > 0u ? mine : 1u; nx = cnt > 0u ? cnt : 1u;
}

__device__ __forceinline__ void xcd_barrier(const XcdBarrier& b) {
    asm volatile("s_waitcnt vmcnt(0)" ::: "memory");
    __syncthreads();
    if (threadIdx.x == 0) {
        unsigned* bar = b.bar;
        __builtin_amdgcn_s_waitcnt(0);
        unsigned nloc = b.st[0], nx = b.st[1];
        if (nloc == 0u) { xcd_barrier_complete(bar, b.x, nloc, nx); b.st[0] = nloc; b.st[1] = nx; }
        const unsigned old = xb_add(&bar[XB_XSUB(b.x)], 1u);
        const unsigned gen = old / nloc;
        if (old + 1u == (gen + 1u) * nloc) {
            __builtin_amdgcn_fence(__ATOMIC_RELEASE, "agent");
            asm volatile("s_waitcnt vmcnt(0)" ::: "memory");
            const unsigned og = xb_add(&bar[XB_TOP], 1u);
            const unsigned tg = og / nx;
            if (og + 1u == (tg + 1u) * nx) xb_add(&bar[XB_TOPGEN], 1u);
            else XB_SPIN(xb_ld(&bar[XB_TOPGEN]) == tg, bar);
            __builtin_amdgcn_fence(__ATOMIC_ACQUIRE, "agent");
            xb_add(&bar[XB_XGEN(b.x)], 1u);
            asm volatile("s_waitcnt vmcnt(0)" ::: "memory");
        } else {
            XB_SPIN(xb_ld(&bar[XB_XGEN(b.x)]) == gen, bar);
            __builtin_amdgcn_fence(__ATOMIC_ACQUIRE, "agent");
            asm volatile("s_waitcnt vmcnt(0)" ::: "memory");
        }
    }
    __syncthreads();
}
constexpr int NWAVES = 8, NT = NWAVES * 64;
constexpr int D = 1024, SEQ = 2048, NB = 8, M = NB * SEQ;
constexpr int DLRU = 512, NH = 8, HD = 64, DIN = 2560, PLE = 256;
constexpr int ZC_X = 0, ZC_G = 512, ZC_Q = 1024, ZC_K = 1536, ZC_V = 2048;
constexpr int NKEY = 128, NSLOT = 128;
constexpr int CH = 64, NCH = SEQ / CH;
constexpr float EPS = 1e-6f;
#ifndef REPP
#define REPP -1
#endif
#ifndef MK_N_LAUNCHES
#define MK_N_LAUNCHES 1
#endif
constexpr int NPHASE = 12;
constexpr int N_LAUNCHES = MK_N_LAUNCHES;

constexpr size_t MiB = 1u << 20;
constexpr size_t WS_CTL = 0, CTL_ZERO_BYTES = 64 * 1024;
constexpr size_t WS_WIN = 1 * MiB, WS_WOUT = 6 * MiB, WS_WCOMB = 8 * MiB, WS_WGATE = 12 * MiB, WS_WPROJ = 14 * MiB;
constexpr size_t WS_SSQ1 = 15 * MiB, WS_RINV2 = 16 * MiB, WS_SSQ3 = 17 * MiB, WS_LRUS = 18 * MiB;
constexpr size_t WS_IDS = 20 * MiB, WS_GW = 28 * MiB, WS_LSE = 36 * MiB, WS_SCL = 19 * MiB;
constexpr size_t WS_A0 = 40 * MiB, WS_A1 = 72 * MiB, WS_Z = 104 * MiB, WS_PU = 184 * MiB, WS_PV = 200 * MiB, WS_POUT = 216 * MiB, WS_P16 = 248 * MiB, WS_END = 256 * MiB;
constexpr int CW_BAR = 4096, CW_QU = 8192, CW_QV = 8192 + 512;

constexpr int RING_BYTES = 131072, LDS_BYTES = 163840, LDSCTL_OFF = LDS_BYTES - 1024, MISC_OFF = LDSCTL_OFF + 320;

__device__ __forceinline__ float bf2f(unsigned short b) { return __uint_as_float(((unsigned)b) << 16); }
__device__ __forceinline__ float bflo(unsigned w) { return __uint_as_float(w << 16); }
__device__ __forceinline__ float bfhi(unsigned w) { return __uint_as_float(w & 0xffff0000u); }
__device__ __forceinline__ float wave_sum(float v) {
#pragma unroll
    for (int o = 1; o < 64; o <<= 1) v += __shfl_xor(v, o);
    return v;
}
__device__ __forceinline__ float wave_max(float v) {
#pragma unroll
    for (int o = 1; o < 64; o <<= 1) v = fmaxf(v, __shfl_xor(v, o));
    return v;
}
__device__ __forceinline__ float gelu_tanh(float x) {
    const float u = 0.7978845608028654f * (x + 0.044715f * x * x * x);
    const float e = __expf(2.0f * u);
    const float th = 1.0f - 2.0f / (e + 1.0f);
    return 0.5f * x * (1.0f + th);
}
__device__ __forceinline__ float sigmoidf_(float x) { return 1.0f / (1.0f + __expf(-x)); }
__device__ __forceinline__ int t5_bucket(int n) {
    if (n < 16) return n;
    const int large = 16 + (int)(logf((float)n / 16.0f) / 4.852030263919617f * 16.0f);
    return large < 31 ? large : 31;
}

__device__ __forceinline__ void p0_transpose_item(const float* W, int K, int N, bf16* WT, LAS float* scr, int item, int lane, const float* gk, int qlo, int qhi) {
    const int nblk = N / 32, kb = item / nblk, nb = item % nblk, k0 = 64 * kb, n0 = 32 * nb;
#pragma unroll 8
    for (int i = 0; i < 32; ++i) { const int kk = 2 * i + (lane >> 5); float v = W[(size_t)(k0 + kk) * N + n0 + (lane & 31)]; if (gk) v *= gk[k0 + kk]; scr[kk * 33 + (lane & 31)] = v; }
    LDS_WAIT(); asm volatile("" ::: "memory");
    const int c = lane & 7;
#pragma unroll
    for (int j = 0; j < 4; ++j) { const int n = (lane >> 3) + 8 * j; const LAS float* s = scr + (8 * c) * 33 + n; const float sc = (n0 + n >= qlo && n0 + n < qhi) ? 0.125f : 1.0f;
        v4u o; o.x = pk2(s[0 * 33] * sc, s[1 * 33] * sc); o.y = pk2(s[2 * 33] * sc, s[3 * 33] * sc); o.z = pk2(s[4 * 33] * sc, s[5 * 33] * sc); o.w = pk2(s[6 * 33] * sc, s[7 * 33] * sc);
        *(GAS v4u*)(WT + (size_t)(n0 + n) * K + k0 + 8 * c) = o; }
    LDS_WAIT(); asm volatile("" ::: "memory");
}

typedef __bf16 bf16x2_t __attribute__((ext_vector_type(2)));
__device__ __forceinline__ float dot2_bf16(unsigned w, unsigned x, float acc) {
    return __builtin_amdgcn_fdot2_f32_bf16(__builtin_bit_cast(bf16x2_t, w), __builtin_bit_cast(bf16x2_t, x), acc, false);
}
struct Args { const float* in[25]; float* out; unsigned char* ws; int ph_lo, ph_hi; };

__global__ void __launch_bounds__(NT, 2) hybrid_fwd(Args args) {
    extern __shared__ __attribute__((aligned(16))) unsigned char lds_raw[];
    LAS unsigned char* lds = (LAS unsigned char*)lds_raw;
    const int tid = threadIdx.x, lane = tid & 63, wave = __builtin_amdgcn_readfirstlane(tid >> 6);
    const int G = gridDim.x, bx = blockIdx.x;
    const int gw = bx * NWAVES + wave, NGW = G * NWAVES;
    unsigned char* ws = args.ws;
    gu32* ctl = (gu32*)(ws + WS_CTL);
    volatile LAS unsigned* MISC = (volatile LAS unsigned*)(lds + MISC_OFF);
    for (int u = tid; u < (LDS_BYTES - LDSCTL_OFF) / 4; u += NT) ((LAS unsigned*)(lds + LDSCTL_OFF))[u] = 0u;
    __syncthreads();
    XcdBarrier bar; bar.bar = (unsigned*)ctl + CW_BAR; bar.x = 0; bar.st = nullptr;
    if (N_LAUNCHES == 1) bar = xcd_barrier_post((unsigned*)ctl + CW_BAR, MISC + 8);
    const int lo = args.ph_lo, hi = args.ph_hi;
#define IN(k) (lo <= (k) && (k) < hi)
#define SEAM(k) do { if (IN(k) && IN((k) + 1)) xcd_barrier(bar); } while (0)

    const float* x = args.in[0]; const float* p_in = args.in[1]; const float* g_mix = args.in[2]; const float* w_in = args.in[3];
    const float* conv_w = args.in[4]; const float* conv_b = args.in[5]; const float* w_rg = args.in[6]; const float* b_rg = args.in[7];
    const float* w_ig = args.in[8]; const float* b_ig = args.in[9]; const float* lam = args.in[10]; const float* g_lru_out = args.in[11];
    const float* g_attn_out = args.in[12]; const float* w_out = args.in[13]; const float* rel_bias = args.in[14]; const float* g_ffn = args.in[15];
    const float* peer_wq = args.in[16]; const float* peer_k1 = args.in[17]; const float* peer_k2 = args.in[18]; const float* peer_u = args.in[19];
    const float* peer_v = args.in[20]; const float* g_ple = args.in[21]; const float* w_ple_gate = args.in[22]; const float* w_ple_proj = args.in[23];
    const float* g_final = args.in[24];
    float* out = args.out;
    bf16* Win_t = (bf16*)(ws + WS_WIN); bf16* Wout_t = (bf16*)(ws + WS_WOUT); bf16* Wcomb_t = (bf16*)(ws + WS_WCOMB); bf16* Wgate_t = (bf16*)(ws + WS_WGATE); bf16* Wproj_t = (bf16*)(ws + WS_WPROJ);
    float* ssq1 = (float*)(ws + WS_SSQ1); float* ssq2 = (float*)(ws + WS_RINV2); float* ssq3 = (float*)(ws + WS_SSQ3); float* lrus = (float*)(ws + WS_LRUS);
    int* ids = (int*)(ws + WS_IDS); float* gwt = (float*)(ws + WS_GW);
    bf16* A0 = (bf16*)(ws + WS_A0); bf16* A1 = (bf16*)(ws + WS_A1); bf16* Z = (bf16*)(ws + WS_Z);
    unsigned char* PU = ws + WS_PU; unsigned char* PV = ws + WS_PV; bf16* P16 = (bf16*)(ws + WS_P16);
    bf16* WGT = (bf16*)(ws + WS_SCL + 512 * 1024);
    float* pscl = (float*)(ws + WS_SCL);
    bf16* HL = A1; bf16* PC = A1 + (size_t)M * DLRU;
    _Float16* S16 = (_Float16*)(ws + WS_Z);
    bf16* Pout = (bf16*)(ws + WS_POUT);

    if (IN(0)) for (int rep_ = 0; rep_ < (REPP == 0 ? 2 : 1); ++rep_) { if (rep_) xcd_barrier(bar);
        {
            LAS float* scr = (LAS float*)(lds + wave * 16384);
            constexpr int I_IN = (D / 64) * (DIN / 32), I_OUT = (D / 64) * (D / 32), I_GATE = I_OUT, I_PROJ = (PLE / 64) * (D / 32);
            constexpr int NITEMS = I_IN + I_OUT + I_GATE + I_PROJ;
            for (int it = gw; it < NITEMS; it += NGW) {
                int r = it;
                if (r < I_IN) { p0_transpose_item(w_in, D, DIN, Win_t, scr, r, lane, nullptr, ZC_Q, ZC_K); continue; } r -= I_IN;
                if (r < I_OUT) { p0_transpose_item(w_out, D, D, Wout_t, scr, r, lane, nullptr, 0, 0); continue; } r -= I_OUT;
                if (r < I_GATE) { p0_transpose_item(w_ple_gate, D, D, Wgate_t, scr, r, lane, g_ple, 0, 0); continue; } r -= I_GATE;
                p0_transpose_item(w_ple_proj, PLE, D, Wproj_t, scr, r, lane, nullptr, 0, 0);
            }
        }
        for (int m0 = 2 * gw; m0 < M; m0 += 2 * NGW) { f32x4 v[2][4];
#pragma unroll
            for (int rr = 0; rr < 2; ++rr) { const GAS f32x4* xr = (const GAS f32x4*)(x + (size_t)(m0 + rr) * D) + lane;
#pragma unroll
                for (int j = 0; j < 4; ++j) v[rr][j] = xr[64 * j]; }
#pragma unroll
            for (int rr = 0; rr < 2; ++rr) { float s2 = 0.f;
#pragma unroll
                for (int j = 0; j < 4; ++j) s2 += (v[rr][j].x * v[rr][j].x + v[rr][j].y * v[rr][j].y) + (v[rr][j].z * v[rr][j].z + v[rr][j].w * v[rr][j].w);
                const float rinv = 1.0f / sqrtf(wave_sum(s2) * (1.f / D) + EPS);
                GAS unsigned long long* o8 = (GAS unsigned long long*)(A0 + (size_t)(m0 + rr) * D) + lane;
#pragma unroll
                for (int j = 0; j < 4; ++j) { const f32x4 g = *((const GAS f32x4*)g_mix + lane + 64 * j);
                    o8[64 * j] = (unsigned long long)pk2(v[rr][j].x * rinv * g.x, v[rr][j].y * rinv * g.y) | ((unsigned long long)pk2(v[rr][j].z * rinv * g.z, v[rr][j].w * rinv * g.w) << 32); } }
        }
        {
            const size_t gt = (size_t)bx * NT + tid, GT = (size_t)G * NT;
            static_assert(((size_t)M * PLE / 4) % (4 * 256 * NT) == 0, "conversion loops are unrolled by 4 over a 256-workgroup grid");
            for (size_t i = gt; i < (size_t)M * PLE / 4; i += 4 * GT) { f32x4 v[4];
#pragma unroll
                for (int k = 0; k < 4; ++k) v[k] = i + k * GT < (size_t)M * PLE / 4 ? ((const GAS f32x4*)p_in)[i + k * GT] : (f32x4){0.f, 0.f, 0.f, 0.f};
#pragma unroll
                for (int k = 0; k < 4; ++k) if (i + k * GT < (size_t)M * PLE / 4) ((GAS unsigned long long*)P16)[i + k * GT] = (unsigned long long)pk2(v[k].x, v[k].y) | ((unsigned long long)pk2(v[k].z, v[k].w) << 32); }
        }
        for (int r0 = 4 * gw; r0 < 2 * 16384; r0 += 4 * NGW) { f32x4 v[4][4];
#pragma unroll
            for (int rr = 0; rr < 4; ++rr) { const int r = r0 + rr; const float* src = (r < 16384 ? peer_u : peer_v) + (size_t)(r & 16383) * D;
#pragma unroll
                for (int k = 0; k < 4; ++k) v[rr][k] = ((const GAS f32x4*)src)[lane + 64 * k]; }
#pragma unroll
            for (int rr = 0; rr < 4; ++rr) { const int r = r0 + rr, e = r & 16383; const bool isu = r < 16384; float am = 0.f;
#pragma unroll
                for (int k = 0; k < 4; ++k) { if (isu) { const f32x4 g = ((const GAS f32x4*)g_ffn)[lane + 64 * k]; v[rr][k].x *= g.x; v[rr][k].y *= g.y; v[rr][k].z *= g.z; v[rr][k].w *= g.w; }
                    am = fmaxf(fmaxf(am, fmaxf(fabsf(v[rr][k].x), fabsf(v[rr][k].y))), fmaxf(fabsf(v[rr][k].z), fabsf(v[rr][k].w))); }
                am = wave_max(am);
                const float isc = am > 0.f ? 416.0f / am : 0.f;
                unsigned char* dst = isu ? PU : PV;
#pragma unroll
                for (int k = 0; k < 4; ++k) { int w = __builtin_amdgcn_cvt_pk_fp8_f32(v[rr][k].x * isc, v[rr][k].y * isc, 0, false); w = __builtin_amdgcn_cvt_pk_fp8_f32(v[rr][k].z * isc, v[rr][k].w * isc, w, true);
                    *(GAS unsigned*)(dst + ((size_t)(2 * k + (lane >> 5)) * 16384 + e) * 128 + 4 * (lane & 31)) = (unsigned)w; }
                if (lane == 0) pscl[r] = am > 0.f ? am * (1.0f / 416.0f) : 0.f; }
        }
        {
            for (int idx = bx * NT + tid; idx < 2 * 8 * 64 * 64; idx += G * NT) { const int gate = idx >> 15, gg = (idx >> 12) & 7, jj = (idx >> 6) & 63, ii = idx & 63;
                WGT[idx] = (bf16)f2bf((gate ? w_ig : w_rg)[(size_t)(gg * 64 + ii) * 64 + jj]); }
        }
        __syncthreads();
        {
            LAS float* ks = (LAS float*)lds;
            LAS float* wqs = (LAS float*)(lds + 65536);
            for (int it = bx; it < 256; it += G) {
                const int hh = it >> 4, d0 = (it & 15) * 64, half = hh & 1;
                const float* kh = half ? peer_k2 : peer_k1;
                for (int i = tid; i < 128 * 128; i += NT) ks[i] = kh[i];
                for (int i = tid; i < 64 * 128; i += NT) { const int dd = i >> 7, c = i & 127; wqs[dd * 129 + c] = peer_wq[(size_t)(d0 + dd) * 2048 + hh * 128 + c]; }
                __syncthreads();
                const int dd = lane, j0 = wave * 16;
                float acc[16];
#pragma unroll
                for (int jj = 0; jj < 16; ++jj) acc[jj] = 0.f;
                for (int c = 0; c < 128; ++c) { const float w = wqs[dd * 129 + c];
#pragma unroll
                    for (int jj = 0; jj < 16; ++jj) acc[jj] += w * ks[(j0 + jj) * 128 + c]; }
                const float gg = g_ffn[d0 + dd];
#pragma unroll
                for (int jj = 0; jj < 16; ++jj) Wcomb_t[(size_t)(hh * 128 + j0 + jj) * D + d0 + dd] = (bf16)f2bf(acc[jj] * gg);
                __syncthreads();
            }
        }
    }
    SEAM(0);

    if (IN(1)) for (int rep_ = 0; rep_ < (REPP == 1 ? 2 : 1); ++rep_) { if (rep_) xcd_barrier(bar);
        pg8::Gemm g{A0, Win_t, M, DIN, D}; pg8::StaticOrder S; S.init(M, DIN, G, bx);
        pg8::EpiBf16<0> E{Z, DIN, nullptr, 0, 0, 1.f};
        pg8::gemm_phase<pg8::EpiBf16<0>, pg8::StaticOrder, PG8_ALIGN, PG8_SP2>(lds, g, S, E);
        {
            const int nshort = G - (int)((size_t)(M / 256) * (DIN / 256) % (size_t)G);
            const bool is_short = (M / 256) * (DIN / 256) % G != 0 && bx >= G - nshort;
            pg8::Gemm gp{P16, Wproj_t, M, D, PLE}; pg8::StaticOrder S2;
            if (is_short) S2.init(M, D, nshort, bx - (G - nshort)); else if ((M / 256) * (DIN / 256) % G == 0) S2.init(M, D, G, bx); else S2.init(M, D, nshort, 1 << 24);
            pg8::EpiBf16<0> E2{Pout, D, nullptr, 0, 0, 1.f};
            pg8::gemm_phase<pg8::EpiBf16<0>, pg8::StaticOrder, PG8_ALIGN, PG8_SP2>(lds, gp, S2, E2);
        }
    }
    SEAM(1);

    if (IN(2)) for (int rep_ = 0; rep_ < (REPP == 2 ? 2 : 1); ++rep_) { if (rep_) xcd_barrier(bar);
        for (int r2_ = 0; r2_ < (REPP == 20 ? 2 : 1); ++r2_)
        for (int it = gw; it < NB * 8 * NCH; it += NGW) {
            const int b = it / (8 * NCH), g = (it / NCH) % 8, chunk = it % NCH, ch = g * 64 + lane, c = lane & 15, gq = lane >> 4;
            LAS unsigned char* XT = lds + wave * 10752; LAS float* AL = (LAS float*)(XT + 2304); LAS float* GL = AL + 1024;
            bf16x8 bw[2][4][2];
#pragma unroll
            for (int gate = 0; gate < 2; ++gate)
#pragma unroll
                for (int nt = 0; nt < 4; ++nt)
#pragma unroll
                    for (int ks = 0; ks < 2; ++ks) bw[gate][nt][ks] = *(const GAS bf16x8*)(WGT + (size_t)((gate * 8 + g) * 64 + 16 * nt + c) * 64 + 32 * ks + 8 * gq);
            float brg[4], big[4], spj[4];
#pragma unroll
            for (int nt = 0; nt < 4; ++nt) { const int j = g * 64 + 16 * nt + c; brg[nt] = b_rg[j]; big[nt] = b_ig[j]; spj[nt] = -8.0f * log1pf(expf(-lam[j])); }
            const float cw0 = conv_w[ch], cw1 = conv_w[512 + ch], cw2 = conv_w[1024 + ch], cw3 = conv_w[1536 + ch], cb = conv_b[ch];
            const int t0 = chunk * CH; const size_t rb = (size_t)b * SEQ;
            float xm3 = t0 >= 3 ? bf2f(Z[(rb + t0 - 3) * DIN + ZC_X + ch]) : 0.f;
            float xm2 = t0 >= 2 ? bf2f(Z[(rb + t0 - 2) * DIN + ZC_X + ch]) : 0.f;
            float xm1 = t0 >= 1 ? bf2f(Z[(rb + t0 - 1) * DIN + ZC_X + ch]) : 0.f;
            float h = 0.f, P = 1.f;
            float xb[16], xn[16];
#pragma unroll
            for (int k = 0; k < 16; ++k) xb[k] = bf2f(Z[(rb + t0 + k) * DIN + ZC_X + ch]);
            for (int blk = 0; blk < CH / 16; ++blk) {
                if (blk + 1 < CH / 16) {
#pragma unroll
                    for (int k = 0; k < 16; ++k) xn[k] = bf2f(Z[(rb + t0 + (blk + 1) * 16 + k) * DIN + ZC_X + ch]); }
                float xc[16];
#pragma unroll
                for (int k = 0; k < 16; ++k) { const float x0 = xb[k]; xc[k] = cw0 * xm3 + cw1 * xm2 + cw2 * xm1 + cw3 * x0 + cb; xm3 = xm2; xm2 = xm1; xm1 = x0;
                    *(LAS unsigned short*)(XT + k * 144 + lane * 2) = (unsigned short)f2bf(xc[k]); }
                LDS_WAIT(); asm volatile("" ::: "memory");
                bf16x8 af[2];
#pragma unroll
                for (int ks = 0; ks < 2; ++ks) af[ks] = *(const LAS bf16x8*)(XT + c * 144 + (32 * ks + 8 * gq) * 2);
#pragma unroll
                for (int nt = 0; nt < 4; ++nt) { f32x4 ar = (f32x4){0.f, 0.f, 0.f, 0.f}, ai = (f32x4){0.f, 0.f, 0.f, 0.f};
#pragma unroll
                    for (int ks = 0; ks < 2; ++ks) { ar = __builtin_amdgcn_mfma_f32_16x16x32_bf16(af[ks], bw[0][nt][ks], ar, 0, 0, 0); ai = __builtin_amdgcn_mfma_f32_16x16x32_bf16(af[ks], bw[1][nt][ks], ai, 0, 0, 0); }
#pragma unroll
                    for (int i = 0; i < 4; ++i) { const float r = sigmoidf_(ar[i] + brg[nt]), ig = sigmoidf_(ai[i] + big[nt]);
                        AL[(4 * gq + i) * 64 + 16 * nt + c] = __expf(r * spj[nt]); GL[(4 * gq + i) * 64 + 16 * nt + c] = ig; } }
                LDS_WAIT(); asm volatile("" ::: "memory");
#pragma unroll
                for (int k = 0; k < 16; ++k) { const size_t row = rb + t0 + blk * 16 + k;
                    const float a = AL[k * 64 + lane], ig = GL[k * 64 + lane];
                    const float bt = sqrtf(fmaxf(1.0f - a * a, 0.f)) * (ig * xc[k]);
                    h = a * h + bt; P = P * a;
                    HL[row * DLRU + ch] = (bf16)f2bf(h); PC[row * DLRU + ch] = (bf16)f2bf(P); }
                LDS_WAIT(); asm volatile("" ::: "memory");
#pragma unroll
                for (int k = 0; k < 16; ++k) xb[k] = xn[k];
            }
            lrus[((size_t)(b * NCH + chunk) * 2 + 0) * DLRU + ch] = P;
            lrus[((size_t)(b * NCH + chunk) * 2 + 1) * DLRU + ch] = h;
        }
        __syncthreads();
        for (int r3_ = 0; r3_ < (REPP == 21 ? 2 : 1); ++r3_) {
            typedef short v4i16_t __attribute__((ext_vector_type(4)));
            constexpr int ABUF = 76288, ABT = 152576;
            bf16* OB = (bf16*)out; float* LSE = (float*)(ws + WS_LSE);
            const int c = lane & 15, g = lane >> 4, q4 = (lane & 15) >> 2, p4 = lane & 3;
            constexpr int NU = NB * NH * 48;
#define ATT_DECODE(u, b_, h_, br_, d_, r_, qb_) do { const int bh_ = (u) / 48, rem_ = (u) - bh_ * 48, w16_ = rem_ & 15; br_ = rem_ >> 4; b_ = bh_ >> 3; h_ = bh_ & 7; d_ = br_ == 0 ? 1 : (br_ == 1 ? 4 : 16); \
        if (br_ == 0) { r_ = 0; qb_ = w16_; } else if (br_ == 1) { r_ = w16_ & 3; qb_ = w16_ >> 2; } else { r_ = w16_; qb_ = 0; } } while (0)
#define ATT_FETCH(b_, h_, d_, r_, qb_) do { _Pragma("unroll") for (int i_ = 0; i_ < 4; ++i_) { const int idx_ = tid + i_ * NT, kb_ = idx_ >> 3, c8_ = idx_ & 7, sp_ = (qb_) * 128 - 128 + kb_; \
            kreg[i_] = (v4u){0u, 0u, 0u, 0u}; vreg[i_] = (v4u){0u, 0u, 0u, 0u}; \
            if (sp_ >= 0) { const size_t row_ = (size_t)(b_) * SEQ + (size_t)sp_ * (d_) + (r_); kreg[i_] = *(const GAS v4u*)(Z + row_ * DIN + ZC_K + (h_) * 64 + c8_ * 8); vreg[i_] = *(const GAS v4u*)(Z + row_ * DIN + ZC_V + (h_) * 64 + c8_ * 8); } } \
        { const size_t qrow_ = (size_t)(b_) * SEQ + (size_t)((qb_) * 128 + 16 * wave + c) * (d_) + (r_); \
          _Pragma("unroll") for (int ks_ = 0; ks_ < 2; ++ks_) qn[ks_] = *(const GAS bf16x8*)(Z + qrow_ * DIN + ZC_Q + (h_) * 64 + ks_ * 32 + g * 8); } } while (0)
#define ATT_STAGE(buf, h_, d_) do { LAS unsigned char* kb2_ = lds + (buf) * ABUF; \
        _Pragma("unroll") for (int i_ = 0; i_ < 4; ++i_) { const int idx_ = tid + i_ * NT, kb_ = idx_ >> 3, c8_ = idx_ & 7; *(LAS v4u*)(kb2_ + kb_ * 144 + c8_ * 16) = kreg[i_]; *(LAS v4u*)(kb2_ + 36864 + kb_ * 144 + c8_ * 16) = vreg[i_]; } \
        if (tid < 176) { const int dist_ = tid - 16; ((LAS float*)(lds + ABT))[(buf) * 176 + tid] = (dist_ >= 0 && dist_ <= 128) ? rel_bias[t5_bucket(dist_ * (d_)) * NH + (h_)] : 0.f; } } while (0)
            v4u kreg[4], vreg[4]; bf16x8 qn[2], qf[2];
            int cb, ch, cbr, cd, cr, cqb;
            if (tid < 256) { const int bsel = tid >> 7, t7 = tid & 127; *(LAS v4u*)(lds + bsel * ABUF + 36864 + (256 + (t7 >> 3)) * 144 + (t7 & 7) * 16) = (v4u){0u, 0u, 0u, 0u}; }
            ATT_DECODE(bx, cb, ch, cbr, cd, cr, cqb);
            ATT_FETCH(cb, ch, cd, cr, cqb);
            ATT_STAGE(0, ch, cd); qf[0] = qn[0]; qf[1] = qn[1];
            __syncthreads();
            int kcur = 0;
            for (int u = bx; u < NU; u += G, kcur ^= 1) {
                const bool has_next = u + G < NU;
                int nb = 0, nh = 0, nbr = 0, nd = 1, nr = 0, nqb = 0;
                if (has_next) { ATT_DECODE(u + G, nb, nh, nbr, nd, nr, nqb); ATT_FETCH(nb, nh, nd, nr, nqb); }
                const LAS unsigned char* Ks = lds + kcur * ABUF; const LAS unsigned char* Vs = Ks + 36864; const LAS float* bt = (const LAS float*)(lds + ABT) + kcur * 176;
                const size_t qrow = (size_t)cb * SEQ + (size_t)(cqb * 128 + 16 * wave + c) * cd + cr;
                f32x4 st[10];
#pragma unroll
                for (int kt = 0; kt < 9; ++kt) { st[kt] = (f32x4){0.f, 0.f, 0.f, 0.f};
#pragma unroll
                    for (int ks = 0; ks < 2; ++ks) { const bf16x8 kf = *(const LAS bf16x8*)(Ks + (16 * wave + 16 * kt + c) * 144 + (ks * 32 + g * 8) * 2);
                        st[kt] = __builtin_amdgcn_mfma_f32_16x16x32_bf16(kf, qf[ks], st[kt], 0, 0, 0); } }
                st[9] = (f32x4){0.f, 0.f, 0.f, 0.f};
                float mx = -3.0e38f;
#pragma unroll
                for (int kt = 0; kt < 9; ++kt)
#pragma unroll
                    for (int i = 0; i < 4; ++i) { const int kbl = 16 * kt + 4 * g + i, dist = 128 + c - kbl;
                        const bool ok = dist >= 0 && dist <= 128 && (cqb > 0 || 16 * wave + kbl >= 128);
                        const float sv = ok ? st[kt][i] + bt[dist + 16] : -3.0e38f; st[kt][i] = sv; mx = fmaxf(mx, sv); }
                mx = fmaxf(mx, __shfl_xor(mx, 16)); mx = fmaxf(mx, __shfl_xor(mx, 32));
                float l = 0.f;
#pragma unroll
                for (int kt = 0; kt < 9; ++kt)
#pragma unroll
                    for (int i = 0; i < 4; ++i) { const float e = st[kt][i] > -1.0e38f ? __expf(st[kt][i] - mx) : 0.f; st[kt][i] = e; l += e; }
                l += __shfl_xor(l, 16); l += __shfl_xor(l, 32);
                f32x4 oacc[4];
#pragma unroll
                for (int nt = 0; nt < 4; ++nt) oacc[nt] = (f32x4){0.f, 0.f, 0.f, 0.f};
#pragma unroll
                for (int kk = 0; kk < 5; ++kk) {
                    union { bf16x8 v; unsigned w[4]; } pf;
                    pf.w[0] = pk2(st[2 * kk][0], st[2 * kk][1]); pf.w[1] = pk2(st[2 * kk][2], st[2 * kk][3]);
                    pf.w[2] = pk2(st[2 * kk + 1][0], st[2 * kk + 1][1]); pf.w[3] = pk2(st[2 * kk + 1][2], st[2 * kk + 1][3]);
#pragma unroll
                    for (int nt = 0; nt < 4; ++nt) {
                        const LAS unsigned char* va = Vs + (16 * wave + 32 * kk + 4 * g + q4) * 144 + (nt * 16 + 4 * p4) * 2;
                        union { bf16x8 v; v4i16_t h[2]; } vf;
                        vf.h[0] = __builtin_amdgcn_ds_read_tr16_b64_v4i16((LAS v4i16_t*)va);
                        vf.h[1] = __builtin_amdgcn_ds_read_tr16_b64_v4i16((LAS v4i16_t*)(va + 16 * 144));
                        oacc[nt] = __builtin_amdgcn_mfma_f32_16x16x32_bf16(vf.v, pf.v, oacc[nt], 0, 0, 0); } }
                const float il = 1.0f / l;
                bf16* op = OB + ((size_t)cbr * M + qrow) * 512 + ch * 64 + 4 * g;
#pragma unroll
                for (int nt = 0; nt < 4; ++nt) { pg8::u32x2 w; w.x = pk2(oacc[nt][0] * il, oacc[nt][1] * il); w.y = pk2(oacc[nt][2] * il, oacc[nt][3] * il); *(GAS pg8::u32x2*)(op + nt * 16) = w; }
                if (g == 0) LSE[((size_t)cbr * M + qrow) * NH + ch] = mx + __logf(l);
                if (has_next) { ATT_STAGE(kcur ^ 1, nh, nd); qf[0] = qn[0]; qf[1] = qn[1]; cb = nb; ch = nh; cbr = nbr; cd = nd; cr = nr; cqb = nqb; }
                __syncthreads();
            }
        }
    }
    SEAM(2);

    if (IN(3)) for (int rep_ = 0; rep_ < (REPP == 3 ? 2 : 1); ++rep_) { if (rep_) xcd_barrier(bar);
        LAS float* carry = (LAS float*)lds;
        const bf16* OB = (const bf16*)out; const float* LSE = (const float*)(ws + WS_LSE);
        for (int it = bx; it < NB * NCH; it += G) {
            const int b = it / NCH, chunk = it % NCH;
            { float hc = 0.f; const int ch = tid;
              for (int c = 0; c < chunk; ++c) { const float a = lrus[((size_t)(b * NCH + c) * 2 + 0) * DLRU + ch], bb = lrus[((size_t)(b * NCH + c) * 2 + 1) * DLRU + ch]; hc = a * hc + bb; }
              __syncthreads(); carry[ch] = hc; __syncthreads(); }
            for (int tt = wave; tt < CH; tt += NWAVES) {
                const size_t row = (size_t)b * SEQ + chunk * CH + tt;
                const v4u hl = *(const GAS v4u*)(HL + row * DLRU + lane * 8), pc = *(const GAS v4u*)(PC + row * DLRU + lane * 8), gt = *(const GAS v4u*)(Z + row * DIN + ZC_G + lane * 8);
                const unsigned hw[4] = {hl.x, hl.y, hl.z, hl.w}, pw[4] = {pc.x, pc.y, pc.z, pc.w}, gv[4] = {gt.x, gt.y, gt.z, gt.w};
                float y[8]; float ss = 0.f;
#pragma unroll
                for (int e = 0; e < 4; ++e) { const float c0 = carry[lane * 8 + 2 * e], c1 = carry[lane * 8 + 2 * e + 1];
                    const float h0 = bflo(hw[e]) + bflo(pw[e]) * c0, h1 = bfhi(hw[e]) + bfhi(pw[e]) * c1;
                    y[2 * e] = h0 * gelu_tanh(bflo(gv[e])); y[2 * e + 1] = h1 * gelu_tanh(bfhi(gv[e])); ss += y[2 * e] * y[2 * e] + y[2 * e + 1] * y[2 * e + 1]; }
                const float rinv = 1.0f / sqrtf(wave_sum(ss) * (1.0f / 512.0f) + EPS);
                const f32x4 g0 = *(const GAS f32x4*)(g_lru_out + lane * 8), g1 = *(const GAS f32x4*)(g_lru_out + lane * 8 + 4);
                v4u o; o.x = pk2(y[0] * rinv * g0.x, y[1] * rinv * g0.y); o.y = pk2(y[2] * rinv * g0.z, y[3] * rinv * g0.w); o.z = pk2(y[4] * rinv * g1.x, y[5] * rinv * g1.y); o.w = pk2(y[6] * rinv * g1.z, y[7] * rinv * g1.w);
                *(GAS v4u*)(A0 + row * D + lane * 8) = o;
                {
                    const int hd = lane >> 3;
                    const float l0 = LSE[((size_t)0 * M + row) * NH + hd], l1 = LSE[((size_t)1 * M + row) * NH + hd], l2 = LSE[((size_t)2 * M + row) * NH + hd];
                    const float mm = fmaxf(l0, fmaxf(l1, l2));
                    float w0 = __expf(l0 - mm), w1 = __expf(l1 - mm), w2 = __expf(l2 - mm); const float iw = 1.0f / (w0 + w1 + w2); w0 *= iw; w1 *= iw; w2 *= iw;
                    const v4u a0 = *(const GAS v4u*)(OB + ((size_t)0 * M + row) * 512 + lane * 8), a1 = *(const GAS v4u*)(OB + ((size_t)1 * M + row) * 512 + lane * 8), a2 = *(const GAS v4u*)(OB + ((size_t)2 * M + row) * 512 + lane * 8);
                    const unsigned u0[4] = {a0.x, a0.y, a0.z, a0.w}, u1[4] = {a1.x, a1.y, a1.z, a1.w}, u2[4] = {a2.x, a2.y, a2.z, a2.w};
                    float ya[8]; float sa = 0.f;
#pragma unroll
                    for (int e = 0; e < 4; ++e) { ya[2 * e] = w0 * bflo(u0[e]) + w1 * bflo(u1[e]) + w2 * bflo(u2[e]); ya[2 * e + 1] = w0 * bfhi(u0[e]) + w1 * bfhi(u1[e]) + w2 * bfhi(u2[e]);
                        sa += ya[2 * e] * ya[2 * e] + ya[2 * e + 1] * ya[2 * e + 1]; }
                    const float ra = 1.0f / sqrtf(wave_sum(sa) * (1.0f / 512.0f) + EPS);
                    const f32x4 ga = *(const GAS f32x4*)(g_attn_out + lane * 8), gb = *(const GAS f32x4*)(g_attn_out + lane * 8 + 4);
                    v4u oa; oa.x = pk2(ya[0] * ra * ga.x, ya[1] * ra * ga.y); oa.y = pk2(ya[2] * ra * ga.z, ya[3] * ra * ga.w); oa.z = pk2(ya[4] * ra * gb.x, ya[5] * ra * gb.y); oa.w = pk2(ya[6] * ra * gb.z, ya[7] * ra * gb.w);
                    *(GAS v4u*)(A0 + row * D + 512 + lane * 8) = oa;
                }
            }
        }
    }
    SEAM(3);

    if (IN(4)) for (int rep_ = 0; rep_ < (REPP == 4 ? 2 : 1); ++rep_) { if (rep_) xcd_barrier(bar);
        pg8::Gemm g{A0, Wout_t, M, D, D}; pg8::StaticOrder S; S.init(M, D, G, bx);
        pg8::EpiResid E{x, out, A1, ssq1};
        pg8::gemm_phase<pg8::EpiResid, pg8::StaticOrder, PG8_ALIGN, PG8_SP2>(lds, g, S, E);
    }
    SEAM(4);

    if (IN(5)) for (int rep_ = 0; rep_ < (REPP == 5 ? 2 : 1); ++rep_) { if (rep_) xcd_barrier(bar);
        pg8::Gemm g{A1, Wcomb_t, M, 2048, D}; pg8::StaticOrder S; S.init(M, 2048, G, bx);
        pg8::EpiScore E{S16, ssq1, EPS};
        pg8::gemm_phase<pg8::EpiScore, pg8::StaticOrder, PG8_ALIGN, PG8_SP2>(lds, g, S, E);
    }
    SEAM(5);

    if (IN(6)) for (int rep_ = 0; rep_ < (REPP == 6 ? 2 : 1); ++rep_) { if (rep_) xcd_barrier(bar);
        for (int item = bx * NT + tid; item < M * NH; item += G * NT) {
            const int tok = item >> 3, h = item & 7;
            const GAS v4u* sp = (const GAS v4u*)(S16 + (size_t)tok * 2048 + h * 256);
            int t1[16], t2[16];
#pragma unroll
            for (int i = 0; i < 16; ++i) { t1[i] = (int)0x80000001; t2[i] = (int)0x80000001; }
#define ROUTE_INS(top, hbits, idx) do { const float f_ = (float)__builtin_bit_cast(_Float16, (unsigned short)(hbits)); \
        int b_ = __float_as_int(f_) | (idx); int x_ = b_ ^ ((b_ >> 31) & 0x7fffffff); \
        _Pragma("unroll") for (int i_ = 0; i_ < 16; ++i_) { const int hi_ = max(top[i_], x_); x_ = min(top[i_], x_); top[i_] = hi_; } } while (0)
            v4u ring[8];
#pragma unroll
            for (int k = 0; k < 4; ++k) { ring[k] = sp[k]; ring[4 + k] = sp[16 + k]; }
#pragma unroll 1
            for (int cb = 0; cb < 16; cb += 4) {
#pragma unroll
                for (int k = 0; k < 4; ++k) { const unsigned w1[4] = {ring[k].x, ring[k].y, ring[k].z, ring[k].w}, w2[4] = {ring[4 + k].x, ring[4 + k].y, ring[4 + k].z, ring[4 + k].w};
                    if (cb < 12) { ring[k] = sp[cb + 4 + k]; ring[4 + k] = sp[16 + cb + 4 + k]; }
                    const int cc = (cb + k) * 8;
#pragma unroll
                    for (int e = 0; e < 4; ++e) { ROUTE_INS(t1, w1[e] & 0xffffu, cc + 2 * e); ROUTE_INS(t2, w2[e] & 0xffffu, cc + 2 * e); ROUTE_INS(t1, w1[e] >> 16, cc + 2 * e + 1); ROUTE_INS(t2, w2[e] >> 16, cc + 2 * e + 1); } } }
#undef ROUTE_INS
            float v1[16], v2[16]; int i1[16], i2[16];
#pragma unroll
            for (int i = 0; i < 16; ++i) { int b1 = t1[i] ^ ((t1[i] >> 31) & 0x7fffffff); i1[i] = b1 & 127; v1[i] = __int_as_float(b1 & ~127);
                                           int b2 = t2[i] ^ ((t2[i] >> 31) & 0x7fffffff); i2[i] = b2 & 127; v2[i] = __int_as_float(b2 & ~127); }
            float ts[16]; int ti[16];
#pragma unroll
            for (int i = 0; i < 16; ++i) { ts[i] = -3.0e38f; ti[i] = 0; }
#pragma unroll
            for (int a = 0; a < 16; ++a)
#pragma unroll
                for (int b = 0; b < 16; ++b) if ((a + 1) * (b + 1) <= 16) {
                    float s = v1[a] + v2[b]; int id = i1[a] * NKEY + i2[b];
#pragma unroll
                    for (int i = 0; i < 16; ++i) { const bool sw = s > ts[i]; const float ns = sw ? s : ts[i], xs = sw ? ts[i] : s; const int ni = sw ? id : ti[i], xi = sw ? ti[i] : id; ts[i] = ns; s = xs; ti[i] = ni; id = xi; }
                }
            float l = 0.f; float e[16];
#pragma unroll
            for (int i = 0; i < 16; ++i) { e[i] = __expf(ts[i] - ts[0]); l += e[i]; }
            const float il = 1.0f / l;
#pragma unroll
            for (int q = 0; q < 8; ++q) { pg8::u32x2 iv; iv.x = (unsigned)ti[q]; iv.y = (unsigned)ti[q + 8]; *(GAS pg8::u32x2*)(ids + (size_t)tok * NSLOT + q * 16 + h * 2) = iv;
                pg8::f32x2 gv; gv.x = e[q] * il; gv.y = e[q + 8] * il; *(GAS pg8::f32x2*)(gwt + (size_t)tok * NSLOT + q * 16 + h * 2) = gv; }
        }
    }
    SEAM(6);

#define PEER_IDS(idr, t) do { const GAS v4u* ipp_ = (const GAS v4u*)(ids + (size_t)(t) * NSLOT + g8 * 16); \
        _Pragma("unroll") for (int q4 = 0; q4 < 4; ++q4) { const v4u w_ = ipp_[q4]; idr[4 * q4] = w_.x; idr[4 * q4 + 1] = w_.y; idr[4 * q4 + 2] = w_.z; idr[4 * q4 + 3] = w_.w; } } while (0)
#define PEER_GATHER(buf, tab, idr) do { _Pragma("unroll") for (int q = 0; q < 16; ++q) buf[q] = *(const GAS v4u*)(tab + ((size_t)j * 16384 + (idr[q] & 0xffffu)) * 128 + c8 * 16); } while (0)
#define ROW_ADD(p, ctrl) p += __int_as_float(__builtin_amdgcn_update_dpp(0, __float_as_int(p), (ctrl), 0xf, 0xf, false))
#define FP8X4(w, f, o) do { const pg8::f32x2 lo_ = __builtin_amdgcn_cvt_pk_f32_fp8((int)(w), false), hi_ = __builtin_amdgcn_cvt_pk_f32_fp8((int)(w), true); f[o] = lo_.x; f[o + 1] = lo_.y; f[o + 2] = hi_.x; f[o + 3] = hi_.y; } while (0)
    if (IN(7)) for (int rep_ = 0; rep_ < (REPP == 7 ? 2 : 1); ++rep_) { if (rep_) xcd_barrier(bar);
        float* SP = (float*)(ws + WS_Z);
        const int home = (int)(xb_xcc_id() & 7u), c8 = lane & 7, g8 = lane >> 3;
#define PEER_XLOAD(xr, t) do { xr[0] = *(const GAS v4u*)(A1 + (size_t)(t) * D + 128 * j + c8 * 16); xr[1] = *(const GAS v4u*)(A1 + (size_t)(t) * D + 128 * j + c8 * 16 + 8); } while (0)
#define PEER_UCONS(buf, xr, t) do { float xf_[16]; { const unsigned xw_[8] = {xr[0].x, xr[0].y, xr[0].z, xr[0].w, xr[1].x, xr[1].y, xr[1].z, xr[1].w}; \
            _Pragma("unroll") for (int e_ = 0; e_ < 8; ++e_) { xf_[2 * e_] = bflo(xw_[e_]); xf_[2 * e_ + 1] = bfhi(xw_[e_]); } } \
        float r0_ = 0.f, r1_ = 0.f; \
        _Pragma("unroll") for (int q = 0; q < 16; ++q) { float f_[16]; FP8X4(buf[q].x, f_, 0); FP8X4(buf[q].y, f_, 4); FP8X4(buf[q].z, f_, 8); FP8X4(buf[q].w, f_, 12); \
            float p_ = 0.f; _Pragma("unroll") for (int e_ = 0; e_ < 16; ++e_) p_ += f_[e_] * xf_[e_]; \
            ROW_ADD(p_, 0xB1); ROW_ADD(p_, 0x4E); ROW_ADD(p_, 0x141); \
            if (q < 8) r0_ = (c8 == q) ? p_ : r0_; else r1_ = (c8 == q - 8) ? p_ : r1_; } \
        float* sp_ = SP + ((size_t)j * M + (t)) * NSLOT + g8 * 16 + c8; sp_[0] = r0_; sp_[8] = r1_; } while (0)
        for (int s = 0; s < 8; ++s) { const int j = (home + s) & 7;
            for (;;) {
                __syncthreads(); if (tid == 0) MISC[16] = __hip_atomic_fetch_add(ctl + CW_QU + rep_ * 1024 + 64 * j, 1u, RLX_AGENT); __syncthreads();
                const int tile = (int)MISC[16]; if (tile >= M / 64) break;
                const int tbase = tile * 64 + wave * 8;
                unsigned idB[16], idN[16]; v4u bA[16], xA[2], xB[2];
                PEER_IDS(idN, tbase); PEER_IDS(idB, tbase + 1);
                PEER_XLOAD(xA, tbase); PEER_GATHER(bA, PU, idN);
                for (int i = 0; i < 8; ++i) { const int t = tbase + i;
                    if (i < 6) PEER_IDS(idN, t + 2);
                    if (i < 7) PEER_XLOAD(xB, t + 1);
                    pg8::f32x2 xf[8]; { const unsigned xw_[8] = {xA[0].x, xA[0].y, xA[0].z, xA[0].w, xA[1].x, xA[1].y, xA[1].z, xA[1].w};
#pragma unroll
                        for (int e = 0; e < 8; ++e) { xf[e].x = bflo(xw_[e]); xf[e].y = bfhi(xw_[e]); } }
                    float r0 = 0.f, r1 = 0.f;
#pragma unroll
                    for (int q = 0; q < 16; ++q) { const unsigned w_[4] = {bA[q].x, bA[q].y, bA[q].z, bA[q].w}; pg8::f32x2 p2 = (pg8::f32x2){0.f, 0.f};
#pragma unroll
                        for (int d = 0; d < 4; ++d) { const pg8::f32x2 lo = __builtin_amdgcn_cvt_pk_f32_fp8((int)w_[d], false), hi = __builtin_amdgcn_cvt_pk_f32_fp8((int)w_[d], true);
                            p2 = __builtin_elementwise_fma(lo, xf[2 * d], p2); p2 = __builtin_elementwise_fma(hi, xf[2 * d + 1], p2); }
                        float p = p2.x + p2.y;
                        if (i < 7) bA[q] = *(const GAS v4u*)(PU + ((size_t)j * 16384 + (idB[q] & 0xffffu)) * 128 + c8 * 16);
                        ROW_ADD(p, 0xB1); ROW_ADD(p, 0x4E); ROW_ADD(p, 0x141);
                        if (q < 8) r0 = (c8 == q) ? p : r0; else r1 = (c8 == q - 8) ? p : r1; }
                    float* sp = SP + ((size_t)j * M + t) * NSLOT + g8 * 16 + c8; sp[0] = r0; sp[8] = r1;
#pragma unroll
                    for (int q = 0; q < 16; ++q) { idB[q] = idN[q]; }
                    xA[0] = xB[0]; xA[1] = xB[1];
                }
            }
        }
    }
    SEAM(7);

    if (IN(8)) {
        {
            const float* SP = (const float*)(ws + WS_Z);
            for (size_t idx = (size_t)bx * NT + tid; idx < (size_t)M * NSLOT; idx += (size_t)G * NT) { const size_t t = idx >> 7; float sum = 0.f;
#pragma unroll
                for (int jj = 0; jj < 8; ++jj) sum += SP[(size_t)jj * M * NSLOT + idx];
                const float rinv1 = 1.0f / sqrtf(pg8::ssq16(ssq1 + t * 16) * (1.0f / 1024.0f) + EPS);
                const unsigned id = (unsigned)ids[idx] & 0xffffu;
                ids[idx] = (int)((f2bf(gelu_tanh(sum * rinv1 * pscl[id]) * gwt[idx] * pscl[16384 + id]) << 16) | id); }
        }
    }
    SEAM(8);

    if (IN(9)) {
        const int home = (int)(xb_xcc_id() & 7u), c8 = lane & 7, g8 = lane >> 3;
#define PEER_VCONS(buf, idr) do { _Pragma("unroll") for (int q = 0; q < 16; ++q) { const float a_ = __uint_as_float(idr[q] & 0xffff0000u); const unsigned w_[4] = {buf[q].x, buf[q].y, buf[q].z, buf[q].w}; \
            _Pragma("unroll") for (int d_ = 0; d_ < 4; ++d_) { const pg8::f32x2 lo_ = __builtin_amdgcn_cvt_pk_f32_fp8((int)w_[d_], false), hi_ = __builtin_amdgcn_cvt_pk_f32_fp8((int)w_[d_], true); \
                acc[4 * d_] += a_ * lo_.x; acc[4 * d_ + 1] += a_ * lo_.y; acc[4 * d_ + 2] += a_ * hi_.x; acc[4 * d_ + 3] += a_ * hi_.y; } \
            if ((q & 3) == 3) __builtin_amdgcn_sched_barrier(0); } } while (0)
#define PEER_VFIN(t) do { asm volatile("" ::: "memory"); \
        _Pragma("unroll") for (int e_ = 0; e_ < 16; ++e_) { ROW_ADD(acc[e_], 0x128); acc[e_] += __shfl_xor(acc[e_], 16); acc[e_] += __shfl_xor(acc[e_], 32); } \
        float ss_ = 0.f; \
        if (g8 == 0) { const GAS v4u* hp_ = (const GAS v4u*)(A1 + (size_t)(t) * D + 128 * j + c8 * 16); const v4u ha_ = hp_[0], hb_ = hp_[1]; \
            const unsigned hw_[8] = {ha_.x, ha_.y, ha_.z, ha_.w, hb_.x, hb_.y, hb_.z, hb_.w}; unsigned ow_[8]; \
            _Pragma("unroll") for (int e_ = 0; e_ < 8; ++e_) { const float h0_ = bflo(hw_[e_]) + acc[2 * e_], h1_ = bfhi(hw_[e_]) + acc[2 * e_ + 1]; ss_ += h0_ * h0_ + h1_ * h1_; ow_[e_] = pk2(h0_, h1_); } \
            v4u o0_, o1_; o0_.x = ow_[0]; o0_.y = ow_[1]; o0_.z = ow_[2]; o0_.w = ow_[3]; o1_.x = ow_[4]; o1_.y = ow_[5]; o1_.z = ow_[6]; o1_.w = ow_[7]; \
            *(GAS v4u*)(A0 + (size_t)(t) * D + 128 * j + c8 * 16) = o0_; *(GAS v4u*)(A0 + (size_t)(t) * D + 128 * j + c8 * 16 + 8) = o1_; } \
        ss_ += __shfl_xor(ss_, 1); ss_ += __shfl_xor(ss_, 2); ss_ += __shfl_xor(ss_, 4); \
        if (lane == 0) ssq2[(size_t)(t) * 8 + j] = ss_; asm volatile("" ::: "memory"); } while (0)
        for (int s = 0; s < 8; ++s) { const int j = (home + s) & 7;
            for (;;) {
                __syncthreads(); if (tid == 0) MISC[16] = __hip_atomic_fetch_add(ctl + CW_QV + 64 * j, 1u, RLX_AGENT); __syncthreads();
                const int tile = (int)MISC[16]; if (tile >= M / 64) break;
                const int tbase = tile * 64 + wave * 8;
                unsigned idA[16], idB[16], idN[16]; v4u bA[16]; pg8::f32x2 acc2[8];
                PEER_IDS(idA, tbase); PEER_IDS(idB, tbase + 1);
                PEER_GATHER(bA, PV, idA);
                for (int i = 0; i < 8; ++i) { const int t = tbase + i;
                    if (i < 6) PEER_IDS(idN, t + 2);
#pragma unroll
                    for (int e = 0; e < 8; ++e) acc2[e] = (pg8::f32x2){0.f, 0.f};
#pragma unroll
                    for (int q = 0; q < 16; ++q) { const float a_ = __uint_as_float(idA[q] & 0xffff0000u); const pg8::f32x2 a2 = (pg8::f32x2){a_, a_}; const unsigned w_[4] = {bA[q].x, bA[q].y, bA[q].z, bA[q].w};
#pragma unroll
                        for (int d = 0; d < 4; ++d) { const pg8::f32x2 lo = __builtin_amdgcn_cvt_pk_f32_fp8((int)w_[d], false), hi = __builtin_amdgcn_cvt_pk_f32_fp8((int)w_[d], true);
                            acc2[2 * d] = __builtin_elementwise_fma(a2, lo, acc2[2 * d]); acc2[2 * d + 1] = __builtin_elementwise_fma(a2, hi, acc2[2 * d + 1]); }
                        if (i < 7) bA[q] = *(const GAS v4u*)(PV + ((size_t)j * 16384 + (idB[q] & 0xffffu)) * 128 + c8 * 16); }
                    float acc[16];
#pragma unroll
                    for (int e = 0; e < 8; ++e) { acc[2 * e] = acc2[e].x; acc[2 * e + 1] = acc2[e].y; }
                    PEER_VFIN(t);
#pragma unroll
                    for (int q = 0; q < 16; ++q) { idA[q] = idB[q]; idB[q] = idN[q]; }
                }
            }
        }
    }
    SEAM(9);


    if (IN(10)) {
        pg8::Gemm g{A0, Wgate_t, M, D, D}; pg8::StaticOrder S; S.init(M, D, G, bx);
        pg8::EpiPle E{out, A0, Pout, ssq2, ssq3, EPS};
        pg8::gemm_phase<pg8::EpiPle, pg8::StaticOrder, PG8_ALIGN, PG8_SP2>(lds, g, S, E);
    }
    SEAM(10);

    if (IN(11)) {
        for (int m = gw; m < M; m += NGW) {
            const float rinv = 1.0f / sqrtf(pg8::ssq16(ssq3 + (size_t)m * 16) * (1.0f / 1024.0f) + EPS);
            GAS f32x4* op = (GAS f32x4*)(out + (size_t)m * D) + lane;
#pragma unroll
            for (int j = 0; j < 4; ++j) { f32x4 v = op[64 * j]; const f32x4 g = *((const GAS f32x4*)g_final + lane + 64 * j);
                v.x *= rinv * g.x; v.y *= rinv * g.y; v.z *= rinv * g.z; v.w *= rinv * g.w; op[64 * j] = v; }
        }
    }
#undef IN
#undef SEAM
}

extern "C" void kernel_launch(void* const* d_in, const int* in_sizes, int n_in, void* d_out, int out_size, void* d_ws, size_t ws_size, hipStream_t stream) {
    static int grid = 0;
    if (grid == 0) {
        if (n_in != 25 || in_sizes[0] != M * D || out_size != M * D || ws_size < WS_END) { fprintf(stderr, "kernel_launch: unexpected shapes (n_in %d, in0 %d, out %d, ws %zu); nothing launched\n", n_in, n_in > 0 ? in_sizes[0] : -1, out_size, ws_size); grid = -1; return; }
        int dev = 0, cus = 0, per_cu = 0;
        if (hipGetDevice(&dev) != hipSuccess || hipDeviceGetAttribute(&cus, hipDeviceAttributeMultiprocessorCount, dev) != hipSuccess) { grid = -1; return; }
        if (hipFuncSetAttribute((const void*)hybrid_fwd, hipFuncAttributeMaxDynamicSharedMemorySize, LDS_BYTES) != hipSuccess) { fprintf(stderr, "kernel_launch: hipFuncSetAttribute failed\n"); grid = -1; return; }
        if (hipOccupancyMaxActiveBlocksPerMultiprocessor(&per_cu, (const void*)hybrid_fwd, NT, LDS_BYTES) != hipSuccess || per_cu < 1)
            fprintf(stderr, "kernel_launch: note: occupancy query reports %d workgroups per CU\n", per_cu);
        (void)hipGetLastError();
        grid = cus;
    }
    if (grid < 0) return;
    if (hipMemsetAsync((char*)d_ws + WS_CTL, 0, CTL_ZERO_BYTES, stream) != hipSuccess) return;
    Args a{};
    for (int i = 0; i < 25; ++i) a.in[i] = (const float*)d_in[i];
    a.out = (float*)d_out; a.ws = (unsigned char*)d_ws;
    if (N_LAUNCHES == 1) { a.ph_lo = 0; a.ph_hi = NPHASE; hipLaunchKernelGGL(hybrid_fwd, dim3(grid), dim3(NT), LDS_BYTES, stream, a); }
    else for (int li = 0; li < NPHASE; ++li) { a.ph_lo = li; a.ph_hi = li + 1; hipLaunchKernelGGL(hybrid_fwd, dim3(grid), dim3(NT), LDS_BYTES, stream, a); }
}
```

```cpp
#include <hip/hip_runtime.h>
#include <cstdio>
#include <cstdint>
namespace pg8 {
#define PG8_LAS __attribute__((address_space(3)))
typedef unsigned short bf16_t;
typedef short bf16x8 __attribute__((ext_vector_type(8)));
typedef float f32x4 __attribute__((ext_vector_type(4)));
typedef unsigned u32x4 __attribute__((ext_vector_type(4)));
constexpr int BM = 256, BK = 64, HALF = 128, HTB = HALF * BK * 2  , STAGE_BYTES = 8 * HTB, NXCD = 8, WGM = 8;

__host__ __device__ __forceinline__ int lds_byte(int r, int c) { const int st = (r >> 4) * 2 + (c >> 5), rr = r & 15, cc = c & 31, ob = rr * 64 + cc * 2; return st * 1024 + (ob ^ (((ob >> 9) & 1) << 5)); }
__host__ __device__ __forceinline__ void stage_rc(int b, int& R, int& C) { const int st = b / 1024, sb = b % 1024, swz = sb ^ (((sb >> 9) & 1) << 5); R = (st >> 1) * 16 + swz / 64; C = (st & 1) * 32 + (swz % 64) / 2; }
__host__ __device__ __forceinline__ int perm32(int rho) { const int n = rho >> 4, i = rho & 15; return 8 * (i >> 2) + 4 * n + (i & 3); }

struct Unit { int pm, pn; };
struct Gemm { const bf16_t* A; const bf16_t* Bt; int M, N, K; };

struct StaticOrder {
    int nM, nN, nwg, G, c;
    __host__ __device__ void init(int M, int N, int G_, int c_) { nM = M / BM; nN = N / BM; nwg = nM * nN; G = G_; c = c_; }
    __host__ __device__ bool next(int i, Unit& u) const {
        const long L = (long)i * G + c; if (L >= nwg) return false;
        int wgid = (int)L; { const int q = nwg / NXCD, r = nwg % NXCD, xcd = wgid % NXCD, off = wgid / NXCD; wgid = (xcd < r ? xcd * (q + 1) : r * (q + 1) + (xcd - r) * q) + off; }
        const int nig = WGM * nN, gid = wgid / nig, fm = gid * WGM, gsz = (nM - fm) < WGM ? (nM - fm) : WGM;
        u.pm = fm + ((wgid % nig) % gsz); u.pn = (wgid % nig) / gsz; return true;
    }
    __device__ __forceinline__ void a_ready(const Unit&) const {}
    __device__ __forceinline__ void done(const Unit&) const {}
};

__device__ __forceinline__ unsigned cvt_pk_bf16(float lo, float hi) { unsigned r; asm volatile("v_cvt_pk_bf16_f32 %0, %1, %2" : "=v"(r) : "v"(lo), "v"(hi)); return r; }
typedef float f32x2 __attribute__((ext_vector_type(2)));
__device__ __forceinline__ f32x2 gelu_pk(f32x2 v) {
    const f32x2 av = __builtin_elementwise_abs(v), d = av * 0.2316418882f + 1.0f;
    f32x2 t; t.x = __builtin_amdgcn_rcpf(d.x); t.y = __builtin_amdgcn_rcpf(d.y);
    f32x2 q = t * 0.5307027145f + (-0.7265760135f); q = q * t + 0.7107068705f; q = q * t + (-0.142248368f); q = q * t + 0.127414796f; q = q * t;
    const f32x2 s = (v * v) * (-0.72134752044f);
    f32x2 e; e.x = __builtin_amdgcn_exp2f(s.x); e.y = __builtin_amdgcn_exp2f(s.y);
    const f32x2 m = v * (q * e), r = v - m;
    f32x2 o; o.x = v.x < 0.f ? m.x : r.x; o.y = v.y < 0.f ? m.y : r.y; return o;
}

template <int ACT  > struct EpiBf16 {
    static constexpr bool PERM = true, AFTER_DRAIN = false; static_assert(ACT == 0 || ACT == 1, "EpiBf16: ACT is 0 (none) or 1 (gelu_pk)");
    bf16_t* O; int ldc; const float* bias; int split_cols; size_t split_stride; float scale0;
    __device__ __forceinline__ void operator()(const f32x4 (&acc)[2][2][4][2], const Unit& u, int wr, int wc, int fr, int fq) const {
        const int row0 = u.pm * BM + wr * 64 + fr; int colt = u.pn * BM; bf16_t* base = O;
        float sc = 1.f; if (split_cols) { const int t = colt / split_cols; base += (size_t)t * split_stride; colt -= t * split_cols; if (t == 0) sc = scale0; }
        const int col0 = colt + wc * 32 + 8 * fq, bcol0 = u.pn * BM + wc * 32 + 8 * fq;
        f32x4 bv[2][2];
#pragma unroll
        for (int bj = 0; bj < 2; ++bj)
#pragma unroll
            for (int n = 0; n < 2; ++n) bv[bj][n] = bias ? *(const f32x4*)(bias + bcol0 + bj * HALF + 4 * n) : (f32x4){0.f, 0.f, 0.f, 0.f};
#pragma unroll
        for (int ai = 0; ai < 2; ++ai)
#pragma unroll
            for (int m = 0; m < 4; ++m) { bf16_t* rowp = base + (size_t)(row0 + ai * HALF + m * 16) * ldc + col0;
#pragma unroll
                for (int bj = 0; bj < 2; ++bj) { f32x4 v0 = acc[ai][bj][m][0] + bv[bj][0], v1 = acc[ai][bj][m][1] + bv[bj][1];
                    if (ACT == 1) { f32x2 a = gelu_pk((f32x2){v0[0], v0[1]}), b = gelu_pk((f32x2){v0[2], v0[3]}), c = gelu_pk((f32x2){v1[0], v1[1]}), d = gelu_pk((f32x2){v1[2], v1[3]});
                        v0 = (f32x4){a.x, a.y, b.x, b.y}; v1 = (f32x4){c.x, c.y, d.x, d.y}; }
                    v0 = v0 * sc; v1 = v1 * sc; u32x4 w; w.x = cvt_pk_bf16(v0[0], v0[1]); w.y = cvt_pk_bf16(v0[2], v0[3]); w.z = cvt_pk_bf16(v1[0], v1[1]); w.w = cvt_pk_bf16(v1[2], v1[3]);
                    *(u32x4*)(rowp + bj * HALF) = w; } }
    }
};
template <class Epi, class Sched, bool ALIGN_EPI = false, bool SP2 = false>
__device__ __forceinline__ void gemm_phase(PG8_LAS unsigned char* lds, const Gemm g, const Sched& S, const Epi& E) {
    const int tid = threadIdx.x, wid = __builtin_amdgcn_readfirstlane(tid >> 6), lane = tid & 63, wr = wid >> 2, wc = wid & 3, fr = lane & 15, fq = lane >> 4;
    const int K = g.K, nt = K / BK;
    unsigned voffA[2], voffB[2];
#pragma unroll
    for (int i = 0; i < 2; ++i) { int R, C; stage_rc(tid * 16 + i * 8192, R, C); const int Rb = Epi::PERM ? ((R & ~31) + perm32(R & 31)) : R;
        voffA[i] = (unsigned)(R * K + C) * 2u; voffB[i] = (unsigned)(Rb * K + C) * 2u; }
    const size_t kstep = (size_t)(BK * 2);
    const size_t hstep = (size_t)HALF * K * 2;
    const size_t tstep = 2 * hstep;
    const unsigned ldsw = (unsigned)wid * 1024u;
    const int aoff = lds_byte(wr * 64 + fr, fq * 8), boff = lds_byte(wc * 32 + fr, fq * 8);
#define PG8_SA(b, h) (((b) * 2 + (h)) * HTB)
#define PG8_SB(b, h) ((4 + (b) * 2 + (h)) * HTB)
#define PG8_STAGE(bufoff, gbase, voff) do { _Pragma("unroll") for (int _i = 0; _i < 2; ++_i) \
        __builtin_amdgcn_global_load_lds((const unsigned*)((const char*)(gbase) + (voff)[_i]), (PG8_LAS unsigned*)(lds + (bufoff) + ldsw + _i * 8192), 16, 0, 0); } while (0)
#define PG8_LDA(dst, b, h) do { _Pragma("unroll") for (int m = 0; m < 4; ++m) _Pragma("unroll") for (int k = 0; k < 2; ++k) dst[m][k] = *(const PG8_LAS bf16x8*)(lds + PG8_SA(b, h) + aoff + m * 2048 + k * 1024); } while (0)
#define PG8_LDB(dst, b, h) do { _Pragma("unroll") for (int n = 0; n < 2; ++n) _Pragma("unroll") for (int k = 0; k < 2; ++k) dst[n][k] = *(const PG8_LAS bf16x8*)(lds + PG8_SB(b, h) + boff + n * 2048 + k * 1024); } while (0)
#define PG8_MMA(ai, bj, At, Bt) do { __builtin_amdgcn_s_setprio(1); _Pragma("unroll") for (int m = 0; m < 4; ++m) _Pragma("unroll") for (int n = 0; n < 2; ++n) _Pragma("unroll") for (int k = 0; k < 2; ++k) \
        acc[ai][bj][m][n] = __builtin_amdgcn_mfma_f32_16x16x32_bf16(Bt[n][k], At[m][k], acc[ai][bj][m][n], 0, 0, 0); __builtin_amdgcn_s_setprio(0); } while (0)
#define PG8_WAIT_V(n) asm volatile("s_waitcnt vmcnt(" #n ")" ::: "memory")
#define PG8_WAIT_L(n) asm volatile("s_waitcnt lgkmcnt(" #n ")" ::: "memory")
#define PG8_BAR __builtin_amdgcn_s_barrier()
#define PG8_SCHED __builtin_amdgcn_sched_barrier(0)
    Unit cur, nxt; int ui = 0;
    if (!S.next(0, cur)) return;
    f32x4 acc[2][2][4][2];
#pragma unroll
    for (int a = 0; a < 2; ++a)
#pragma unroll
        for (int b = 0; b < 2; ++b)
#pragma unroll
            for (int m = 0; m < 4; ++m)
#pragma unroll
                for (int n = 0; n < 2; ++n) acc[a][b][m][n] = (f32x4){0.f, 0.f, 0.f, 0.f};
    bf16x8 At[4][2], B0[2][2], B1[2][2];
    const char* cA = (const char*)g.A + (size_t)cur.pm * tstep; const char* cB = (const char*)g.Bt + (size_t)cur.pn * tstep;
    S.a_ready(cur);
    if constexpr (SP2) {
        PG8_STAGE(PG8_SB(0, 0), cB, voffB); PG8_STAGE(PG8_SB(0, 1), cB + hstep, voffB); PG8_STAGE(PG8_SA(0, 0), cA, voffA); PG8_STAGE(PG8_SA(0, 1), cA + hstep, voffA);
        if (wr == 1) PG8_BAR;
        PG8_WAIT_V(2); PG8_BAR;
        PG8_STAGE(PG8_SB(1, 0), cB + kstep, voffB); PG8_STAGE(PG8_SA(1, 0), cA + kstep, voffA); PG8_STAGE(PG8_SB(1, 1), cB + hstep + kstep, voffB);
        PG8_WAIT_V(6); PG8_BAR;
    } else {
        PG8_STAGE(PG8_SB(0, 0), cB, voffB); PG8_STAGE(PG8_SA(0, 0), cA, voffA); PG8_STAGE(PG8_SB(0, 1), cB + hstep, voffB); PG8_STAGE(PG8_SA(0, 1), cA + hstep, voffA);
        if (wr == 1) PG8_BAR;
        PG8_WAIT_V(4); PG8_BAR;
        PG8_STAGE(PG8_SB(1, 0), cB + kstep, voffB); PG8_STAGE(PG8_SA(1, 0), cA + kstep, voffA); PG8_STAGE(PG8_SB(1, 1), cB + hstep + kstep, voffB);
        PG8_WAIT_V(6); PG8_BAR;
    }
    for (;;) {
        const bool has_next = S.next(ui + 1, nxt);
        const char* nA = has_next ? (const char*)g.A + (size_t)nxt.pm * tstep : cA; const char* nB = has_next ? (const char*)g.Bt + (size_t)nxt.pn * tstep : cB;
        for (int t = 0; t < nt; t += 2) {
            const bool last = (t == nt - 2);
            const char* a1 = cA + (size_t)(t + 1) * kstep;
            const char* a2 = last ? nA : cA + (size_t)(t + 2) * kstep; const char* b2 = last ? nB : cB + (size_t)(t + 2) * kstep;
            const char* a3 = a2 + kstep; const char* b3 = b2 + kstep;
            if (last && has_next) S.a_ready(nxt);
            if constexpr (SP2) {
            PG8_LDB(B0, 0, 0); PG8_LDB(B1, 0, 1); PG8_SCHED; PG8_LDA(At, 0, 0); PG8_STAGE(PG8_SA(1, 1), a1 + hstep, voffA);
            PG8_WAIT_V(8); PG8_WAIT_L(0); PG8_BAR; PG8_MMA(0, 0, At, B0); PG8_MMA(0, 1, At, B1); PG8_BAR; PG8_SCHED;
            PG8_LDA(At, 0, 1); PG8_STAGE(PG8_SB(0, 0), b2, voffB); PG8_STAGE(PG8_SB(0, 1), b2 + hstep, voffB); PG8_STAGE(PG8_SA(0, 0), a2, voffA);
            PG8_WAIT_V(8); PG8_WAIT_L(0); PG8_BAR; PG8_MMA(1, 0, At, B0); PG8_MMA(1, 1, At, B1); PG8_BAR; PG8_SCHED;
            PG8_LDB(B0, 1, 0); PG8_LDB(B1, 1, 1); PG8_SCHED; PG8_LDA(At, 1, 0); PG8_STAGE(PG8_SA(0, 1), a2 + hstep, voffA);
            PG8_WAIT_V(8); PG8_WAIT_L(0); PG8_BAR; PG8_MMA(0, 0, At, B0); PG8_MMA(0, 1, At, B1); PG8_BAR; PG8_SCHED;
            PG8_LDA(At, 1, 1); PG8_STAGE(PG8_SB(1, 0), b3, voffB); PG8_STAGE(PG8_SB(1, 1), b3 + hstep, voffB); PG8_STAGE(PG8_SA(1, 0), a3, voffA);
            PG8_WAIT_V(8); PG8_WAIT_L(0); PG8_BAR; PG8_MMA(1, 0, At, B0); PG8_MMA(1, 1, At, B1); PG8_BAR; PG8_SCHED;
            } else {
            PG8_LDB(B0, 0, 0); PG8_SCHED; PG8_LDA(At, 0, 0); PG8_STAGE(PG8_SA(1, 1), a1 + hstep, voffA);
            PG8_WAIT_L(8); PG8_BAR; PG8_WAIT_L(0); PG8_MMA(0, 0, At, B0); PG8_BAR; PG8_SCHED;
            PG8_LDB(B1, 0, 1); PG8_STAGE(PG8_SB(0, 0), b2, voffB);
            PG8_BAR; PG8_WAIT_L(0); PG8_MMA(0, 1, At, B1); PG8_BAR;
            PG8_LDA(At, 0, 1); PG8_STAGE(PG8_SA(0, 0), a2, voffA);
            PG8_BAR; PG8_WAIT_L(0); PG8_MMA(1, 0, At, B0); PG8_BAR; PG8_SCHED;
            PG8_STAGE(PG8_SB(0, 1), b2 + hstep, voffB);
            PG8_WAIT_V(6); PG8_BAR; PG8_MMA(1, 1, At, B1); PG8_BAR;
            PG8_LDB(B0, 1, 0); PG8_SCHED; PG8_LDA(At, 1, 0); PG8_STAGE(PG8_SA(0, 1), a2 + hstep, voffA);
            PG8_WAIT_L(8); PG8_BAR; PG8_WAIT_L(0); PG8_MMA(0, 0, At, B0); PG8_BAR; PG8_SCHED;
            PG8_LDB(B1, 1, 1); PG8_STAGE(PG8_SB(1, 0), b3, voffB);
            PG8_BAR; PG8_WAIT_L(0); PG8_MMA(0, 1, At, B1); PG8_BAR;
            PG8_LDA(At, 1, 1); PG8_STAGE(PG8_SA(1, 0), a3, voffA);
            PG8_BAR; PG8_WAIT_L(0); PG8_MMA(1, 0, At, B0); PG8_BAR; PG8_SCHED;
            PG8_STAGE(PG8_SB(1, 1), b3 + hstep, voffB);
            PG8_WAIT_V(6); PG8_BAR; PG8_MMA(1, 1, At, B1); PG8_BAR;
            }
        }
        if constexpr (ALIGN_EPI) { if (wr == 0) PG8_BAR; }
        if constexpr (!Epi::AFTER_DRAIN) { E(acc, cur, wr, wc, fr, fq); S.done(cur); }
        if (!has_next) break;
#pragma unroll
        for (int a = 0; a < 2; ++a)
#pragma unroll
            for (int b = 0; b < 2; ++b)
#pragma unroll
                for (int m = 0; m < 4; ++m)
#pragma unroll
                    for (int n = 0; n < 2; ++n) acc[a][b][m][n] = (f32x4){0.f, 0.f, 0.f, 0.f};
        cur = nxt; cA = nA; cB = nB; ++ui;
        if constexpr (ALIGN_EPI) { if (wr == 1) PG8_BAR; }
    }
    PG8_WAIT_V(0);
    if constexpr (!ALIGN_EPI) { if (wr == 0) PG8_BAR; }
    PG8_BAR;
    if constexpr (Epi::AFTER_DRAIN) { E.fused(acc, cur, wr, wc, fr, fq, lds, wid, lane); S.done(cur); }
#undef PG8_SA
#undef PG8_SB
#undef PG8_STAGE
#undef PG8_LDA
#undef PG8_LDB
#undef PG8_MMA
#undef PG8_WAIT_V
#undef PG8_WAIT_L
#undef PG8_BAR
#undef PG8_SCHED
}
}
namespace pg8 {
typedef unsigned u32x2 __attribute__((ext_vector_type(2)));
__device__ __forceinline__ float ssq16(const float* p) {
    const f32x4 a = *(const f32x4*)p, b = *(const f32x4*)(p + 4), c = *(const f32x4*)(p + 8), d = *(const f32x4*)(p + 12);
    return ((a[0] + a[1]) + (a[2] + a[3])) + ((b[0] + b[1]) + (b[2] + b[3])) + ((c[0] + c[1]) + (c[2] + c[3])) + ((d[0] + d[1]) + (d[2] + d[3]));
}
struct EpiResid {
    static constexpr bool PERM = false, AFTER_DRAIN = false;
    const float* resid; float* out; bf16_t* ob; float* ssq;
    __device__ __forceinline__ void operator()(const f32x4 (&acc)[2][2][4][2], const Unit& u, int wr, int wc, int fr, int fq) const {
        const int row0 = u.pm * BM + wr * 64 + fr, col0 = u.pn * BM + wc * 32 + 4 * fq;
#pragma unroll
        for (int ai = 0; ai < 2; ++ai)
#pragma unroll
            for (int m = 0; m < 4; ++m) { const int row = row0 + ai * HALF + m * 16; const size_t off = (size_t)row * 1024 + col0; float ss = 0.f;
#pragma unroll
                for (int bj = 0; bj < 2; ++bj)
#pragma unroll
                    for (int n = 0; n < 2; ++n) { const int co = bj * HALF + n * 16; const f32x4 v = acc[ai][bj][m][n] + *(const f32x4*)(resid + off + co);
                        ss += (v[0] * v[0] + v[1] * v[1]) + (v[2] * v[2] + v[3] * v[3]);
                        u32x2 w; w.x = cvt_pk_bf16(v[0], v[1]); w.y = cvt_pk_bf16(v[2], v[3]); *(u32x2*)(ob + off + co) = w; }
                ss += __shfl_xor(ss, 16); ss += __shfl_xor(ss, 32);
                if (fq == 0) ssq[(size_t)row * 16 + u.pn * 4 + wc] = ss; }
    }
};
struct EpiScore {
    static constexpr bool PERM = true, AFTER_DRAIN = false;
    _Float16* S; const float* ssq; float eps;
    __device__ __forceinline__ void operator()(const f32x4 (&acc)[2][2][4][2], const Unit& u, int wr, int wc, int fr, int fq) const {
        typedef _Float16 h2 __attribute__((ext_vector_type(2)));
        const int row0 = u.pm * BM + wr * 64 + fr, col0 = u.pn * BM + wc * 32 + 8 * fq;
#pragma unroll
        for (int ai = 0; ai < 2; ++ai)
#pragma unroll
            for (int m = 0; m < 4; ++m) { const int row = row0 + ai * HALF + m * 16;
                const float rinv = __builtin_amdgcn_rsqf(ssq16(ssq + (size_t)row * 16) * (1.0f / 1024.0f) + eps);
                _Float16* rowp = S + (size_t)row * 2048 + col0;
#pragma unroll
                for (int bj = 0; bj < 2; ++bj) { const f32x4 v0 = acc[ai][bj][m][0] * rinv, v1 = acc[ai][bj][m][1] * rinv;
                    u32x4 w; h2 t;
                    t.x = (_Float16)v0[0]; t.y = (_Float16)v0[1]; w.x = __builtin_bit_cast(unsigned, t);
                    t.x = (_Float16)v0[2]; t.y = (_Float16)v0[3]; w.y = __builtin_bit_cast(unsigned, t);
                    t.x = (_Float16)v1[0]; t.y = (_Float16)v1[1]; w.z = __builtin_bit_cast(unsigned, t);
                    t.x = (_Float16)v1[2]; t.y = (_Float16)v1[3]; w.w = __builtin_bit_cast(unsigned, t);
                    *(u32x4*)(rowp + bj * HALF) = w; } }
    }
};
struct EpiPle {
    static constexpr bool PERM = false, AFTER_DRAIN = false;
    float* io; const bf16_t* hin; const bf16_t* P; const float* ssq_in; float* ssq; float eps;
    __device__ __forceinline__ void operator()(const f32x4 (&acc)[2][2][4][2], const Unit& u, int wr, int wc, int fr, int fq) const {
        const int row0 = u.pm * BM + wr * 64 + fr, col0 = u.pn * BM + wc * 32 + 4 * fq;
#pragma unroll
        for (int ai = 0; ai < 2; ++ai)
#pragma unroll
            for (int m = 0; m < 4; ++m) { const int row = row0 + ai * HALF + m * 16; const size_t off = (size_t)row * 1024 + col0; float ss = 0.f; const f32x4 qa = *(const f32x4*)(ssq_in + (size_t)row * 8), qb = *(const f32x4*)(ssq_in + (size_t)row * 8 + 4); const float ri = __builtin_amdgcn_rsqf((((qa[0] + qa[1]) + (qa[2] + qa[3])) + ((qb[0] + qb[1]) + (qb[2] + qb[3]))) * (1.0f / 1024.0f) + eps);
#pragma unroll
                for (int bj = 0; bj < 2; ++bj)
#pragma unroll
                    for (int n = 0; n < 2; ++n) { const int co = bj * HALF + n * 16; const f32x4 a = acc[ai][bj][m][n] * ri; const u32x2 hw = *(const u32x2*)(hin + off + co); f32x4 h; h[0] = __uint_as_float(hw.x << 16); h[1] = __uint_as_float(hw.x & 0xffff0000u); h[2] = __uint_as_float(hw.y << 16); h[3] = __uint_as_float(hw.y & 0xffff0000u);
                        const u32x2 pw = *(const u32x2*)(P + off + co);
                        f32x4 pv; pv[0] = __uint_as_float(pw.x << 16); pv[1] = __uint_as_float(pw.x & 0xffff0000u); pv[2] = __uint_as_float(pw.y << 16); pv[3] = __uint_as_float(pw.y & 0xffff0000u);
                        f32x4 v;
#pragma unroll
                        for (int j = 0; j < 4; ++j) v[j] = h[j] + pv[j] / (1.0f + __expf(-a[j]));
                        *(f32x4*)(io + off + co) = v; ss += (v[0] * v[0] + v[1] * v[1]) + (v[2] * v[2] + v[3] * v[3]); }
                ss += __shfl_xor(ss, 16); ss += __shfl_xor(ss, 32);
                if (fq == 0) ssq[(size_t)row * 16 + u.pn * 4 + wc] = ss; }
    }
};
}
#ifndef PG8_SP2
#define PG8_SP2 true
#endif
#ifndef PG8_ALIGN
#define PG8_ALIGN true
#endif
#define GAS __attribute__((address_space(1)))
#define LAS __attribute__((address_space(3)))
typedef unsigned short bf16;
typedef unsigned v4u __attribute__((ext_vector_type(4)));
typedef float f32x4 __attribute__((ext_vector_type(4)));
typedef short bf16x8 __attribute__((ext_vector_type(8)));
typedef GAS unsigned gu32;
typedef GAS unsigned long long gu64;
#define RLX_AGENT __ATOMIC_RELAXED, __HIP_MEMORY_SCOPE_AGENT
#define LDS_WAIT() asm volatile("s_waitcnt lgkmcnt(0)" ::: "memory")
#define VM_WAIT() asm volatile("s_waitcnt vmcnt(0)" ::: "memory")
__device__ __forceinline__ unsigned long long rt() { return __builtin_amdgcn_s_memrealtime(); }
__device__ __forceinline__ unsigned f2bf(float f) { unsigned u = __builtin_bit_cast(unsigned, f); return (u + 0x7fffu + ((u >> 16) & 1u)) >> 16; }
__device__ __forceinline__ unsigned pk2(float lo, float hi) { return f2bf(lo) | (f2bf(hi) << 16); }

#define XB_TMO      128
#define XB_XCNT(j)  (256  + 64 * (j))
#define XB_XSUB(j)  (1280 + 64 * (j))
#define XB_XGEN(j)  (2304 + 64 * (j))
#define XB_TOP      3328
#define XB_TOPGEN   3392
#define XCD_BAR_WORDS 3456
#define XB_SPIN_CAP (1u << 18)

__device__ __forceinline__ unsigned xb_ld(unsigned* p)              { return __hip_atomic_load(p, __ATOMIC_RELAXED, __HIP_MEMORY_SCOPE_AGENT); }
__device__ __forceinline__ unsigned xb_add(unsigned* p, unsigned v) { return __hip_atomic_fetch_add(p, v, __ATOMIC_RELAXED, __HIP_MEMORY_SCOPE_AGENT); }
__device__ __forceinline__ unsigned xb_xcc_id() { return (unsigned)__builtin_amdgcn_s_getreg((3 << 11) | 20) & 0xFu; }
#define XB_SPIN(cond, bar) do { unsigned _sp = 0; while (cond) { __builtin_amdgcn_s_sleep(1); \
    if ((++_sp & 255u) == 0u) { if (xb_ld(&(bar)[XB_TMO])) break; if (_sp > XB_SPIN_CAP) { atomicAdd(&(bar)[XB_TMO], 1u); break; } } } } while (0)

struct XcdBarrier {
    unsigned* bar; unsigned x;
    volatile LAS unsigned* st;
};

__device__ __forceinline__ XcdBarrier xcd_barrier_post(unsigned* bar, volatile LAS unsigned* st) {
    XcdBarrier b; b.bar = bar; b.x = xb_xcc_id(); b.st = st;
    if (threadIdx.x == 0) (void)xb_add(&bar[XB_XCNT(b.x)], 1u);
    return b;
}
__device__ __forceinline__ void xcd_barrier_complete(unsigned* bar, unsigned x, unsigned& nloc, unsigned& nx) {
    const unsigned G = gridDim.x * gridDim.y * gridDim.z;
    unsigned sum, cnt, mine, sp = 0u;
    for (;;) {
        sum = 0u; cnt = 0u; mine = 0u;
#pragma unroll
        for (unsigned j = 0; j < 16; ++j) { const unsigned c = xb_ld(&bar[XB_XCNT(j)]); sum += c; cnt += (c > 0u) ? 1u : 0u; mine = (j == x) ? c : mine; }
        if (sum == G) break;
        __builtin_amdgcn_s_sleep(1);
        if ((++sp & 255u) == 0u) { if (xb_ld(&bar[XB_TMO])) break; if (sp > XB_SPIN_CAP) { atomicAdd(&bar[XB_TMO], 1u); break; } }
    }
    nloc = mine > 0u ? mine : 1u; nx = cnt > 0u ? cnt : 1u;
}

__device__ __forceinline__ void xcd_barrier(const XcdBarrier& b) {
    asm volatile("s_waitcnt vmcnt(0)" ::: "memory");
    __syncthreads();
    if (threadIdx.x == 0) {
        unsigned* bar = b.bar;
        __builtin_amdgcn_s_waitcnt(0);
        unsigned nloc = b.st[0], nx = b.st[1];
        if (nloc == 0u) { xcd_barrier_complete(bar, b.x, nloc, nx); b.st[0] = nloc; b.st[1] = nx; }
        const unsigned old = xb_add(&bar[XB_XSUB(b.x)], 1u);
        const unsigned gen = old / nloc;
        if (old + 1u == (gen + 1u) * nloc) {
            __builtin_amdgcn_fence(__ATOMIC_RELEASE, "agent");
            asm volatile("s_waitcnt vmcnt(0)" ::: "memory");
            const unsigned og = xb_add(&bar[XB_TOP], 1u);
            const unsigned tg = og / nx;
            if (og + 1u == (tg + 1u) * nx) xb_add(&bar[XB_TOPGEN], 1u);
            else XB_SPIN(xb_ld(&bar[XB_TOPGEN]) == tg, bar);
            __builtin_amdgcn_fence(__ATOMIC_ACQUIRE, "agent");
            xb_add(&bar[XB_XGEN(b.x)], 1u);
            asm volatile("s_waitcnt vmcnt(0)" ::: "memory");
        } else {
            XB_SPIN(xb_ld(&bar[XB_XGEN(b.x)]) == gen, bar);
            __builtin_amdgcn_fence(__ATOMIC_ACQUIRE, "agent");
            asm volatile("s_waitcnt vmcnt(0)" ::: "memory");
        }
    }
    __syncthreads();
}
constexpr int NWAVES = 8, NT = NWAVES * 64;
constexpr int D = 1024, SEQ = 2048, NB = 8, M = NB * SEQ;
constexpr int DLRU = 512, NH = 8, HD = 64, DIN = 2560, PLE = 256;
constexpr int ZC_X = 0, ZC_G = 512, ZC_Q = 1024, ZC_K = 1536, ZC_V = 2048;
constexpr int NKEY = 128, NSLOT = 128;
constexpr int CH = 64, NCH = SEQ / CH;
constexpr float EPS = 1e-6f;
#ifndef REPP
#define REPP -1
#endif
#ifndef MK_N_LAUNCHES
#define MK_N_LAUNCHES 1
#endif
constexpr int NPHASE = 12;
constexpr int N_LAUNCHES = MK_N_LAUNCHES;

constexpr size_t MiB = 1u << 20;
constexpr size_t WS_CTL = 0, CTL_ZERO_BYTES = 64 * 1024;
constexpr size_t WS_WIN = 1 * MiB, WS_WOUT = 6 * MiB, WS_WCOMB = 8 * MiB, WS_WGATE = 12 * MiB, WS_WPROJ = 14 * MiB;
constexpr size_t WS_SSQ1 = 15 * MiB, WS_RINV2 = 16 * MiB, WS_SSQ3 = 17 * MiB, WS_LRUS = 18 * MiB;
constexpr size_t WS_IDS = 20 * MiB, WS_GW = 28 * MiB, WS_LSE = 36 * MiB, WS_SCL = 19 * MiB;
constexpr size_t WS_A0 = 40 * MiB, WS_A1 = 72 * MiB, WS_Z = 104 * MiB, WS_PU = 184 * MiB, WS_PV = 200 * MiB, WS_POUT = 216 * MiB, WS_P16 = 248 * MiB, WS_END = 256 * MiB;
constexpr int CW_BAR = 4096, CW_QU = 8192, CW_QV = 8192 + 512;

constexpr int RING_BYTES = 131072, LDS_BYTES = 163840, LDSCTL_OFF = LDS_BYTES - 1024, MISC_OFF = LDSCTL_OFF + 320;

__device__ __forceinline__ float bf2f(unsigned short b) { return __uint_as_float(((unsigned)b) << 16); }
__device__ __forceinline__ float bflo(unsigned w) { return __uint_as_float(w << 16); }
__device__ __forceinline__ float bfhi(unsigned w) { return __uint_as_float(w & 0xffff0000u); }
__device__ __forceinline__ float wave_sum(float v) {
#pragma unroll
    for (int o = 1; o < 64; o <<= 1) v += __shfl_xor(v, o);
    return v;
}
__device__ __forceinline__ float wave_max(float v) {
#pragma unroll
    for (int o = 1; o < 64; o <<= 1) v = fmaxf(v, __shfl_xor(v, o));
    return v;
}
__device__ __forceinline__ float gelu_tanh(float x) {
    const float u = 0.7978845608028654f * (x + 0.044715f * x * x * x);
    const float e = __expf(2.0f * u);
    const float th = 1.0f - 2.0f / (e + 1.0f);
    return 0.5f * x * (1.0f + th);
}
__device__ __forceinline__ float sigmoidf_(float x) { return 1.0f / (1.0f + __expf(-x)); }
__device__ __forceinline__ int t5_bucket(int n) {
    if (n < 16) return n;
    const int large = 16 + (int)(logf((float)n / 16.0f) / 4.852030263919617f * 16.0f);
    return large < 31 ? large : 31;
}

__device__ __forceinline__ void p0_transpose_item(const float* W, int K, int N, bf16* WT, LAS float* scr, int item, int lane, const float* gk, int qlo, int qhi) {
    const int nblk = N / 32, kb = item / nblk, nb = item % nblk, k0 = 64 * kb, n0 = 32 * nb;
#pragma unroll 8
    for (int i = 0; i < 32; ++i) { const int kk = 2 * i + (lane >> 5); float v = W[(size_t)(k0 + kk) * N + n0 + (lane & 31)]; if (gk) v *= gk[k0 + kk]; scr[kk * 33 + (lane & 31)] = v; }
    LDS_WAIT(); asm volatile("" ::: "memory");
    const int c = lane & 7;
#pragma unroll
    for (int j = 0; j < 4; ++j) { const int n = (lane >> 3) + 8 * j; const LAS float* s = scr + (8 * c) * 33 + n; const float sc = (n0 + n >= qlo && n0 + n < qhi) ? 0.125f : 1.0f;
        v4u o; o.x = pk2(s[0 * 33] * sc, s[1 * 33] * sc); o.y = pk2(s[2 * 33] * sc, s[3 * 33] * sc); o.z = pk2(s[4 * 33] * sc, s[5 * 33] * sc); o.w = pk2(s[6 * 33] * sc, s[7 * 33] * sc);
        *(GAS v4u*)(WT + (size_t)(n0 + n) * K + k0 + 8 * c) = o; }
    LDS_WAIT(); asm volatile("" ::: "memory");
}

#define RT_HD __device__ __forceinline__
#ifndef RT_HD
#define RT_HD __host__ __device__ __forceinline__
#endif
RT_HD int rt_max(int a, int b) { return a > b ? a : b; }
RT_HD int rt_min(int a, int b) { return a < b ? a : b; }
#define RT_CE(a, b) do { const int hi_ = rt_max(a, b), lo_ = rt_min(a, b); a = hi_; b = lo_; } while (0)
RT_HD void rt_sort16(int (&v)[16]) {
#pragma unroll
    for (int k = 2; k <= 16; k <<= 1)
#pragma unroll
        for (int j = k >> 1; j > 0; j >>= 1)
#pragma unroll
            for (int i = 0; i < 16; ++i) { const int l = i ^ j; if (l > i) { if ((i & k) == 0) RT_CE(v[i], v[l]); else RT_CE(v[l], v[i]); } }
}
RT_HD void rt_merge16(int (&top)[16], const int (&bat)[16]) {
#pragma unroll
    for (int i = 0; i < 16; ++i) top[i] = rt_max(top[i], bat[15 - i]);
#pragma unroll
    for (int j = 8; j > 0; j >>= 1)
#pragma unroll
        for (int i = 0; i < 16; ++i) { const int l = i ^ j; if (l > i) RT_CE(top[i], top[l]); }
}
RT_HD int rt_key(unsigned hbits, int idx) {
#if defined(__HIP_DEVICE_COMPILE__)
    const float f = (float)__builtin_bit_cast(_Float16, (unsigned short)hbits);
    int b = __float_as_int(f) | idx;
#else
    const float f = (float)__builtin_bit_cast(_Float16, (unsigned short)hbits);
    int b; { unsigned u; __builtin_memcpy(&u, &f, 4); b = (int)(u | (unsigned)idx); }
#endif
    return b ^ ((b >> 31) & 0x7fffffff);
}
RT_HD int rt_unkey(int k) { return k ^ ((k >> 31) & 0x7fffffff); }
RT_HD int rt_ckey(float s, int ab) {
#if defined(__HIP_DEVICE_COMPILE__)
    int b = (__float_as_int(s) & ~255) | ab;
#else
    unsigned u; __builtin_memcpy(&u, &s, 4); int b = (int)((u & ~255u) | (unsigned)ab);
#endif
    return b ^ ((b >> 31) & 0x7fffffff);
}
RT_HD float rt_f(int bits) {
#if defined(__HIP_DEVICE_COMPILE__)
    return __int_as_float(bits);
#else
    float f; __builtin_memcpy(&f, &bits, 4); return f;
#endif
}
RT_HD void rt_pairs(const int (&top1)[16], const int (&top2)[16], int (&tk)[16]) {
    float v1[16], v2[16];
#pragma unroll
    for (int i = 0; i < 16; ++i) { v1[i] = rt_f(rt_unkey(top1[i]) & ~127); v2[i] = rt_f(rt_unkey(top2[i]) & ~127); }
    int bat[16]; int n = 0, nb = 0;
#pragma unroll
    for (int a = 0; a < 16; ++a)
#pragma unroll
        for (int b = 0; b < 16; ++b) if ((a + 1) * (b + 1) <= 16) {
            bat[n] = rt_ckey(v1[a] + v2[b], a * 16 + b); ++n;
            if (n == 16) { rt_sort16(bat); if (nb == 0) {
#pragma unroll
                for (int i = 0; i < 16; ++i) tk[i] = bat[i]; } else rt_merge16(tk, bat); n = 0; ++nb; } }
#pragma unroll
    for (int i = 0; i < 16; ++i) if (i >= n) bat[i] = (int)0x80000001;
    rt_sort16(bat); rt_merge16(tk, bat);
}

typedef __bf16 bf16x2_t __attribute__((ext_vector_type(2)));
__device__ __forceinline__ float dot2_bf16(unsigned w, unsigned x, float acc) {
    return __builtin_amdgcn_fdot2_f32_bf16(__builtin_bit_cast(bf16x2_t, w), __builtin_bit_cast(bf16x2_t, x), acc, false);
}
struct Args { const float* in[25]; float* out; unsigned char* ws; int ph_lo, ph_hi; };

__global__ void __launch_bounds__(NT, 2) hybrid_fwd(Args args) {
    extern __shared__ __attribute__((aligned(16))) unsigned char lds_raw[];
    LAS unsigned char* lds = (LAS unsigned char*)lds_raw;
    const int tid = threadIdx.x, lane = tid & 63, wave = __builtin_amdgcn_readfirstlane(tid >> 6);
    const int G = gridDim.x, bx = blockIdx.x;
    const int gw = bx * NWAVES + wave, NGW = G * NWAVES;
    unsigned char* ws = args.ws;
    gu32* ctl = (gu32*)(ws + WS_CTL);
    volatile LAS unsigned* MISC = (volatile LAS unsigned*)(lds + MISC_OFF);
    for (int u = tid; u < (LDS_BYTES - LDSCTL_OFF) / 4; u += NT) ((LAS unsigned*)(lds + LDSCTL_OFF))[u] = 0u;
    __syncthreads();
    XcdBarrier bar; bar.bar = (unsigned*)ctl + CW_BAR; bar.x = 0; bar.st = nullptr;
    if (N_LAUNCHES == 1) bar = xcd_barrier_post((unsigned*)ctl + CW_BAR, MISC + 8);
    const int lo = args.ph_lo, hi = args.ph_hi;
#define IN(k) (lo <= (k) && (k) < hi)
#define SEAM(k) do { if (IN(k) && IN((k) + 1)) xcd_barrier(bar); } while (0)

    const float* x = args.in[0]; const float* p_in = args.in[1]; const float* g_mix = args.in[2]; const float* w_in = args.in[3];
    const float* conv_w = args.in[4]; const float* conv_b = args.in[5]; const float* w_rg = args.in[6]; const float* b_rg = args.in[7];
    const float* w_ig = args.in[8]; const float* b_ig = args.in[9]; const float* lam = args.in[10]; const float* g_lru_out = args.in[11];
    const float* g_attn_out = args.in[12]; const float* w_out = args.in[13]; const float* rel_bias = args.in[14]; const float* g_ffn = args.in[15];
    const float* peer_wq = args.in[16]; const float* peer_k1 = args.in[17]; const float* peer_k2 = args.in[18]; const float* peer_u = args.in[19];
    const float* peer_v = args.in[20]; const float* g_ple = args.in[21]; const float* w_ple_gate = args.in[22]; const float* w_ple_proj = args.in[23];
    const float* g_final = args.in[24];
    float* out = args.out;
    bf16* Win_t = (bf16*)(ws + WS_WIN); bf16* Wout_t = (bf16*)(ws + WS_WOUT); bf16* Wcomb_t = (bf16*)(ws + WS_WCOMB); bf16* Wgate_t = (bf16*)(ws + WS_WGATE); bf16* Wproj_t = (bf16*)(ws + WS_WPROJ);
    float* ssq1 = (float*)(ws + WS_SSQ1); float* ssq2 = (float*)(ws + WS_RINV2); float* ssq3 = (float*)(ws + WS_SSQ3); float* lrus = (float*)(ws + WS_LRUS);
    int* ids = (int*)(ws + WS_IDS); float* gwt = (float*)(ws + WS_GW);
    bf16* A0 = (bf16*)(ws + WS_A0); bf16* A1 = (bf16*)(ws + WS_A1); bf16* Z = (bf16*)(ws + WS_Z);
    unsigned char* PU = ws + WS_PU; unsigned char* PV = ws + WS_PV; bf16* P16 = (bf16*)(ws + WS_P16);
    bf16* WGT = (bf16*)(ws + WS_SCL + 512 * 1024);
    float* pscl = (float*)(ws + WS_SCL);
    bf16* HL = A1; bf16* PC = A1 + (size_t)M * DLRU;
    _Float16* S16 = (_Float16*)(ws + WS_Z);
    bf16* Pout = (bf16*)(ws + WS_POUT);

    if (IN(0)) for (int rep_ = 0; rep_ < (REPP == 0 ? 2 : 1); ++rep_) { if (rep_) xcd_barrier(bar);
        {
            LAS float* scr = (LAS float*)(lds + wave * 16384);
            constexpr int I_IN = (D / 64) * (DIN / 32), I_OUT = (D / 64) * (D / 32), I_GATE = I_OUT, I_PROJ = (PLE / 64) * (D / 32);
            constexpr int NITEMS = I_IN + I_OUT + I_GATE + I_PROJ;
            for (int it = gw; it < NITEMS; it += NGW) {
                int r = it;
                if (r < I_IN) { p0_transpose_item(w_in, D, DIN, Win_t, scr, r, lane, nullptr, ZC_Q, ZC_K); continue; } r -= I_IN;
                if (r < I_OUT) { p0_transpose_item(w_out, D, D, Wout_t, scr, r, lane, nullptr, 0, 0); continue; } r -= I_OUT;
                if (r < I_GATE) { p0_transpose_item(w_ple_gate, D, D, Wgate_t, scr, r, lane, g_ple, 0, 0); continue; } r -= I_GATE;
                p0_transpose_item(w_ple_proj, PLE, D, Wproj_t, scr, r, lane, nullptr, 0, 0);
            }
        }
        for (int m0 = 2 * gw; m0 < M; m0 += 2 * NGW) { f32x4 v[2][4];
#pragma unroll
            for (int rr = 0; rr < 2; ++rr) { const GAS f32x4* xr = (const GAS f32x4*)(x + (size_t)(m0 + rr) * D) + lane;
#pragma unroll
                for (int j = 0; j < 4; ++j) v[rr][j] = xr[64 * j]; }
#pragma unroll
            for (int rr = 0; rr < 2; ++rr) { float s2 = 0.f;
#pragma unroll
                for (int j = 0; j < 4; ++j) s2 += (v[rr][j].x * v[rr][j].x + v[rr][j].y * v[rr][j].y) + (v[rr][j].z * v[rr][j].z + v[rr][j].w * v[rr][j].w);
                const float rinv = 1.0f / sqrtf(wave_sum(s2) * (1.f / D) + EPS);
                GAS unsigned long long* o8 = (GAS unsigned long long*)(A0 + (size_t)(m0 + rr) * D) + lane;
#pragma unroll
                for (int j = 0; j < 4; ++j) { const f32x4 g = *((const GAS f32x4*)g_mix + lane + 64 * j);
                    o8[64 * j] = (unsigned long long)pk2(v[rr][j].x * rinv * g.x, v[rr][j].y * rinv * g.y) | ((unsigned long long)pk2(v[rr][j].z * rinv * g.z, v[rr][j].w * rinv * g.w) << 32); } }
        }
        {
            const size_t gt = (size_t)bx * NT + tid, GT = (size_t)G * NT;
            static_assert(((size_t)M * PLE / 4) % (4 * 256 * NT) == 0, "conversion loops are unrolled by 4 over a 256-workgroup grid");
            for (size_t i = gt; i < (size_t)M * PLE / 4; i += 4 * GT) { f32x4 v[4];
#pragma unroll
                for (int k = 0; k < 4; ++k) v[k] = i + k * GT < (size_t)M * PLE / 4 ? ((const GAS f32x4*)p_in)[i + k * GT] : (f32x4){0.f, 0.f, 0.f, 0.f};
#pragma unroll
                for (int k = 0; k < 4; ++k) if (i + k * GT < (size_t)M * PLE / 4) ((GAS unsigned long long*)P16)[i + k * GT] = (unsigned long long)pk2(v[k].x, v[k].y) | ((unsigned long long)pk2(v[k].z, v[k].w) << 32); }
        }
        for (int r0 = 4 * gw; r0 < 2 * 16384; r0 += 4 * NGW) { f32x4 v[4][4];
#pragma unroll
            for (int rr = 0; rr < 4; ++rr) { const int r = r0 + rr; const float* src = (r < 16384 ? peer_u : peer_v) + (size_t)(r & 16383) * D;
#pragma unroll
                for (int k = 0; k < 4; ++k) v[rr][k] = ((const GAS f32x4*)src)[lane + 64 * k]; }
#pragma unroll
            for (int rr = 0; rr < 4; ++rr) { const int r = r0 + rr, e = r & 16383; const bool isu = r < 16384; float am = 0.f;
#pragma unroll
                for (int k = 0; k < 4; ++k) { if (isu) { const f32x4 g = ((const GAS f32x4*)g_ffn)[lane + 64 * k]; v[rr][k].x *= g.x; v[rr][k].y *= g.y; v[rr][k].z *= g.z; v[rr][k].w *= g.w; }
                    am = fmaxf(fmaxf(am, fmaxf(fabsf(v[rr][k].x), fabsf(v[rr][k].y))), fmaxf(fabsf(v[rr][k].z), fabsf(v[rr][k].w))); }
                am = wave_max(am);
                const float isc = am > 0.f ? 416.0f / am : 0.f;
                unsigned char* dst = isu ? PU : PV;
#pragma unroll
                for (int k = 0; k < 4; ++k) { int w = __builtin_amdgcn_cvt_pk_fp8_f32(v[rr][k].x * isc, v[rr][k].y * isc, 0, false); w = __builtin_amdgcn_cvt_pk_fp8_f32(v[rr][k].z * isc, v[rr][k].w * isc, w, true);
                    *(GAS unsigned*)(dst + ((size_t)(2 * k + (lane >> 5)) * 16384 + e) * 128 + 4 * (lane & 31)) = (unsigned)w; }
                if (lane == 0) pscl[r] = am > 0.f ? am * (1.0f / 416.0f) : 0.f; }
        }
        {
            for (int idx = bx * NT + tid; idx < 2 * 8 * 64 * 64; idx += G * NT) { const int gate = idx >> 15, gg = (idx >> 12) & 7, jj = (idx >> 6) & 63, ii = idx & 63;
                WGT[idx] = (bf16)f2bf((gate ? w_ig : w_rg)[(size_t)(gg * 64 + ii) * 64 + jj]); }
        }
        __syncthreads();
        {
            LAS float* ks = (LAS float*)lds;
            LAS float* wqs = (LAS float*)(lds + 65536);
            for (int it = bx; it < 256; it += G) {
                const int hh = it >> 4, d0 = (it & 15) * 64, half = hh & 1;
                const float* kh = half ? peer_k2 : peer_k1;
                for (int i = tid; i < 128 * 128; i += NT) ks[i] = kh[i];
                for (int i = tid; i < 64 * 128; i += NT) { const int dd = i >> 7, c = i & 127; wqs[dd * 129 + c] = peer_wq[(size_t)(d0 + dd) * 2048 + hh * 128 + c]; }
                __syncthreads();
                const int dd = lane, j0 = wave * 16;
                float acc[16];
#pragma unroll
                for (int jj = 0; jj < 16; ++jj) acc[jj] = 0.f;
                for (int c = 0; c < 128; ++c) { const float w = wqs[dd * 129 + c];
#pragma unroll
                    for (int jj = 0; jj < 16; ++jj) acc[jj] += w * ks[(j0 + jj) * 128 + c]; }
                const float gg = g_ffn[d0 + dd];
#pragma unroll
                for (int jj = 0; jj < 16; ++jj) Wcomb_t[(size_t)(hh * 128 + j0 + jj) * D + d0 + dd] = (bf16)f2bf(acc[jj] * gg);
                __syncthreads();
            }
        }
    }
    SEAM(0);

    if (IN(1)) for (int rep_ = 0; rep_ < (REPP == 1 ? 2 : 1); ++rep_) { if (rep_) xcd_barrier(bar);
        pg8::Gemm g{A0, Win_t, M, DIN, D}; pg8::StaticOrder S; S.init(M, DIN, G, bx);
        pg8::EpiBf16<0> E{Z, DIN, nullptr, 0, 0, 1.f};
        pg8::gemm_phase<pg8::EpiBf16<0>, pg8::StaticOrder, PG8_ALIGN, PG8_SP2>(lds, g, S, E);
        {
            const int nshort = G - (int)((size_t)(M / 256) * (DIN / 256) % (size_t)G);
            const bool is_short = (M / 256) * (DIN / 256) % G != 0 && bx >= G - nshort;
            pg8::Gemm gp{P16, Wproj_t, M, D, PLE}; pg8::StaticOrder S2;
            if (is_short) S2.init(M, D, nshort, bx - (G - nshort)); else if ((M / 256) * (DIN / 256) % G == 0) S2.init(M, D, G, bx); else S2.init(M, D, nshort, 1 << 24);
            pg8::EpiBf16<0> E2{Pout, D, nullptr, 0, 0, 1.f};
            pg8::gemm_phase<pg8::EpiBf16<0>, pg8::StaticOrder, PG8_ALIGN, PG8_SP2>(lds, gp, S2, E2);
        }
    }
    SEAM(1);

    if (IN(2)) for (int rep_ = 0; rep_ < (REPP == 2 ? 2 : 1); ++rep_) { if (rep_) xcd_barrier(bar);
        for (int r2_ = 0; r2_ < (REPP == 20 ? 2 : 1); ++r2_)
        for (int it = gw; it < NB * 8 * NCH; it += NGW) {
            const int b = it / (8 * NCH), g = (it / NCH) % 8, chunk = it % NCH, ch = g * 64 + lane, c = lane & 15, gq = lane >> 4;
            LAS unsigned char* XT = lds + wave * 10752; LAS float* AL = (LAS float*)(XT + 2304); LAS float* GL = AL + 1024;
            bf16x8 bw[2][4][2];
#pragma unroll
            for (int gate = 0; gate < 2; ++gate)
#pragma unroll
                for (int nt = 0; nt < 4; ++nt)
#pragma unroll
                    for (int ks = 0; ks < 2; ++ks) bw[gate][nt][ks] = *(const GAS bf16x8*)(WGT + (size_t)((gate * 8 + g) * 64 + 16 * nt + c) * 64 + 32 * ks + 8 * gq);
            float brg[4], big[4], spj[4];
#pragma unroll
            for (int nt = 0; nt < 4; ++nt) { const int j = g * 64 + 16 * nt + c; brg[nt] = b_rg[j]; big[nt] = b_ig[j]; spj[nt] = -8.0f * log1pf(expf(-lam[j])); }
            const float cw0 = conv_w[ch], cw1 = conv_w[512 + ch], cw2 = conv_w[1024 + ch], cw3 = conv_w[1536 + ch], cb = conv_b[ch];
            const int t0 = chunk * CH; const size_t rb = (size_t)b * SEQ;
            float xm3 = t0 >= 3 ? bf2f(Z[(rb + t0 - 3) * DIN + ZC_X + ch]) : 0.f;
            float xm2 = t0 >= 2 ? bf2f(Z[(rb + t0 - 2) * DIN + ZC_X + ch]) : 0.f;
            float xm1 = t0 >= 1 ? bf2f(Z[(rb + t0 - 1) * DIN + ZC_X + ch]) : 0.f;
            float h = 0.f, P = 1.f;
            float xb[16], xn[16];
#pragma unroll
            for (int k = 0; k < 16; ++k) xb[k] = bf2f(Z[(rb + t0 + k) * DIN + ZC_X + ch]);
            for (int blk = 0; blk < CH / 16; ++blk) {
                if (blk + 1 < CH / 16) {
#pragma unroll
                    for (int k = 0; k < 16; ++k) xn[k] = bf2f(Z[(rb + t0 + (blk + 1) * 16 + k) * DIN + ZC_X + ch]); }
                float xc[16];
#pragma unroll
                for (int k = 0; k < 16; ++k) { const float x0 = xb[k]; xc[k] = cw0 * xm3 + cw1 * xm2 + cw2 * xm1 + cw3 * x0 + cb; xm3 = xm2; xm2 = xm1; xm1 = x0;
                    *(LAS unsigned short*)(XT + k * 144 + lane * 2) = (unsigned short)f2bf(xc[k]); }
                LDS_WAIT(); asm volatile("" ::: "memory");
                bf16x8 af[2];
#pragma unroll
                for (int ks = 0; ks < 2; ++ks) af[ks] = *(const LAS bf16x8*)(XT + c * 144 + (32 * ks + 8 * gq) * 2);
#pragma unroll
                for (int nt = 0; nt < 4; ++nt) { f32x4 ar = (f32x4){0.f, 0.f, 0.f, 0.f}, ai = (f32x4){0.f, 0.f, 0.f, 0.f};
#pragma unroll
                    for (int ks = 0; ks < 2; ++ks) { ar = __builtin_amdgcn_mfma_f32_16x16x32_bf16(af[ks], bw[0][nt][ks], ar, 0, 0, 0); ai = __builtin_amdgcn_mfma_f32_16x16x32_bf16(af[ks], bw[1][nt][ks], ai, 0, 0, 0); }
#pragma unroll
                    for (int i = 0; i < 4; ++i) { const float r = sigmoidf_(ar[i] + brg[nt]), ig = sigmoidf_(ai[i] + big[nt]);
                        AL[(4 * gq + i) * 64 + 16 * nt + c] = __expf(r * spj[nt]); GL[(4 * gq + i) * 64 + 16 * nt + c] = ig; } }
                LDS_WAIT(); asm volatile("" ::: "memory");
#pragma unroll
                for (int k = 0; k < 16; ++k) { const size_t row = rb + t0 + blk * 16 + k;
                    const float a = AL[k * 64 + lane], ig = GL[k * 64 + lane];
                    const float bt = sqrtf(fmaxf(1.0f - a * a, 0.f)) * (ig * xc[k]);
                    h = a * h + bt; P = P * a;
                    HL[row * DLRU + ch] = (bf16)f2bf(h); PC[row * DLRU + ch] = (bf16)f2bf(P); }
                LDS_WAIT(); asm volatile("" ::: "memory");
#pragma unroll
                for (int k = 0; k < 16; ++k) xb[k] = xn[k];
            }
            lrus[((size_t)(b * NCH + chunk) * 2 + 0) * DLRU + ch] = P;
            lrus[((size_t)(b * NCH + chunk) * 2 + 1) * DLRU + ch] = h;
        }
        __syncthreads();
        for (int r3_ = 0; r3_ < (REPP == 21 ? 2 : 1); ++r3_) {
            typedef short v4i16_t __attribute__((ext_vector_type(4)));
            constexpr int ABUF = 76288, ABT = 152576;
            bf16* OB = (bf16*)out; float* LSE = (float*)(ws + WS_LSE);
            const int c = lane & 15, g = lane >> 4, q4 = (lane & 15) >> 2, p4 = lane & 3;
            constexpr int NU = NB * NH * 48;
#define ATT_DECODE(u, b_, h_, br_, d_, r_, qb_) do { const int bh_ = (u) / 48, rem_ = (u) - bh_ * 48, w16_ = rem_ & 15; br_ = rem_ >> 4; b_ = bh_ >> 3; h_ = bh_ & 7; d_ = br_ == 0 ? 1 : (br_ == 1 ? 4 : 16); \
        if (br_ == 0) { r_ = 0; qb_ = w16_; } else if (br_ == 1) { r_ = w16_ & 3; qb_ = w16_ >> 2; } else { r_ = w16_; qb_ = 0; } } while (0)
#define ATT_FETCH(b_, h_, d_, r_, qb_) do { _Pragma("unroll") for (int i_ = 0; i_ < 4; ++i_) { const int idx_ = tid + i_ * NT, kb_ = idx_ >> 3, c8_ = idx_ & 7, sp_ = (qb_) * 128 - 128 + kb_; \
            kreg[i_] = (v4u){0u, 0u, 0u, 0u}; vreg[i_] = (v4u){0u, 0u, 0u, 0u}; \
            if (sp_ >= 0) { const size_t row_ = (size_t)(b_) * SEQ + (size_t)sp_ * (d_) + (r_); kreg[i_] = *(const GAS v4u*)(Z + row_ * DIN + ZC_K + (h_) * 64 + c8_ * 8); vreg[i_] = *(const GAS v4u*)(Z + row_ * DIN + ZC_V + (h_) * 64 + c8_ * 8); } } \
        { const size_t qrow_ = (size_t)(b_) * SEQ + (size_t)((qb_) * 128 + 16 * wave + c) * (d_) + (r_); \
          _Pragma("unroll") for (int ks_ = 0; ks_ < 2; ++ks_) qn[ks_] = *(const GAS bf16x8*)(Z + qrow_ * DIN + ZC_Q + (h_) * 64 + ks_ * 32 + g * 8); } } while (0)
#define ATT_STAGE(buf, h_, d_) do { LAS unsigned char* kb2_ = lds + (buf) * ABUF; \
        _Pragma("unroll") for (int i_ = 0; i_ < 4; ++i_) { const int idx_ = tid + i_ * NT, kb_ = idx_ >> 3, c8_ = idx_ & 7; *(LAS v4u*)(kb2_ + kb_ * 144 + c8_ * 16) = kreg[i_]; *(LAS v4u*)(kb2_ + 36864 + kb_ * 144 + c8_ * 16) = vreg[i_]; } \
        if (tid < 176) { const int dist_ = tid - 16; ((LAS float*)(lds + ABT))[(buf) * 176 + tid] = (dist_ >= 0 && dist_ <= 128) ? rel_bias[t5_bucket(dist_ * (d_)) * NH + (h_)] : 0.f; } } while (0)
            v4u kreg[4], vreg[4]; bf16x8 qn[2], qf[2];
            int cb, ch, cbr, cd, cr, cqb;
            if (tid < 256) { const int bsel = tid >> 7, t7 = tid & 127; *(LAS v4u*)(lds + bsel * ABUF + 36864 + (256 + (t7 >> 3)) * 144 + (t7 & 7) * 16) = (v4u){0u, 0u, 0u, 0u}; }
            ATT_DECODE(bx, cb, ch, cbr, cd, cr, cqb);
            ATT_FETCH(cb, ch, cd, cr, cqb);
            ATT_STAGE(0, ch, cd); qf[0] = qn[0]; qf[1] = qn[1];
            __syncthreads();
            int kcur = 0;
            for (int u = bx; u < NU; u += G, kcur ^= 1) {
                const bool has_next = u + G < NU;
                int nb = 0, nh = 0, nbr = 0, nd = 1, nr = 0, nqb = 0;
                if (has_next) { ATT_DECODE(u + G, nb, nh, nbr, nd, nr, nqb); ATT_FETCH(nb, nh, nd, nr, nqb); }
                const LAS unsigned char* Ks = lds + kcur * ABUF; const LAS unsigned char* Vs = Ks + 36864; const LAS float* bt = (const LAS float*)(lds + ABT) + kcur * 176;
                const size_t qrow = (size_t)cb * SEQ + (size_t)(cqb * 128 + 16 * wave + c) * cd + cr;
                f32x4 st[10];
#pragma unroll
                for (int kt = 0; kt < 9; ++kt) { st[kt] = (f32x4){0.f, 0.f, 0.f, 0.f};
#pragma unroll
                    for (int ks = 0; ks < 2; ++ks) { const bf16x8 kf = *(const LAS bf16x8*)(Ks + (16 * wave + 16 * kt + c) * 144 + (ks * 32 + g * 8) * 2);
                        st[kt] = __builtin_amdgcn_mfma_f32_16x16x32_bf16(kf, qf[ks], st[kt], 0, 0, 0); } }
                st[9] = (f32x4){0.f, 0.f, 0.f, 0.f};
                float mx = -3.0e38f;
#pragma unroll
                for (int kt = 0; kt < 9; ++kt)
#pragma unroll
                    for (int i = 0; i < 4; ++i) { const int kbl = 16 * kt + 4 * g + i, dist = 128 + c - kbl;
                        const bool ok = dist >= 0 && dist <= 128 && (cqb > 0 || 16 * wave + kbl >= 128);
                        const float sv = ok ? st[kt][i] + bt[dist + 16] : -3.0e38f; st[kt][i] = sv; mx = fmaxf(mx, sv); }
                mx = fmaxf(mx, __shfl_xor(mx, 16)); mx = fmaxf(mx, __shfl_xor(mx, 32));
                float l = 0.f;
#pragma unroll
                for (int kt = 0; kt < 9; ++kt)
#pragma unroll
                    for (int i = 0; i < 4; ++i) { const float e = st[kt][i] > -1.0e38f ? __expf(st[kt][i] - mx) : 0.f; st[kt][i] = e; l += e; }
                l += __shfl_xor(l, 16); l += __shfl_xor(l, 32);
                f32x4 oacc[4];
#pragma unroll
                for (int nt = 0; nt < 4; ++nt) oacc[nt] = (f32x4){0.f, 0.f, 0.f, 0.f};
#pragma unroll
                for (int kk = 0; kk < 5; ++kk) {
                    union { bf16x8 v; unsigned w[4]; } pf;
                    pf.w[0] = pk2(st[2 * kk][0], st[2 * kk][1]); pf.w[1] = pk2(st[2 * kk][2], st[2 * kk][3]);
                    pf.w[2] = pk2(st[2 * kk + 1][0], st[2 * kk + 1][1]); pf.w[3] = pk2(st[2 * kk + 1][2], st[2 * kk + 1][3]);
#pragma unroll
                    for (int nt = 0; nt < 4; ++nt) {
                        const LAS unsigned char* va = Vs + (16 * wave + 32 * kk + 4 * g + q4) * 144 + (nt * 16 + 4 * p4) * 2;
                        union { bf16x8 v; v4i16_t h[2]; } vf;
                        vf.h[0] = __builtin_amdgcn_ds_read_tr16_b64_v4i16((LAS v4i16_t*)va);
                        vf.h[1] = __builtin_amdgcn_ds_read_tr16_b64_v4i16((LAS v4i16_t*)(va + 16 * 144));
                        oacc[nt] = __builtin_amdgcn_mfma_f32_16x16x32_bf16(vf.v, pf.v, oacc[nt], 0, 0, 0); } }
                const float il = 1.0f / l;
                bf16* op = OB + ((size_t)cbr * M + qrow) * 512 + ch * 64 + 4 * g;
#pragma unroll
                for (int nt = 0; nt < 4; ++nt) { pg8::u32x2 w; w.x = pk2(oacc[nt][0] * il, oacc[nt][1] * il); w.y = pk2(oacc[nt][2] * il, oacc[nt][3] * il); *(GAS pg8::u32x2*)(op + nt * 16) = w; }
                if (g == 0) LSE[((size_t)cbr * M + qrow) * NH + ch] = mx + __logf(l);
                if (has_next) { ATT_STAGE(kcur ^ 1, nh, nd); qf[0] = qn[0]; qf[1] = qn[1]; cb = nb; ch = nh; cbr = nbr; cd = nd; cr = nr; cqb = nqb; }
                __syncthreads();
            }
        }
    }
    SEAM(2);

    if (IN(3)) for (int rep_ = 0; rep_ < (REPP == 3 ? 2 : 1); ++rep_) { if (rep_) xcd_barrier(bar);
        LAS float* carry = (LAS float*)lds;
        const bf16* OB = (const bf16*)out; const float* LSE = (const float*)(ws + WS_LSE);
        for (int it = bx; it < NB * NCH; it += G) {
            const int b = it / NCH, chunk = it % NCH;
            { float hc = 0.f; const int ch = tid;
              for (int c = 0; c < chunk; ++c) { const float a = lrus[((size_t)(b * NCH + c) * 2 + 0) * DLRU + ch], bb = lrus[((size_t)(b * NCH + c) * 2 + 1) * DLRU + ch]; hc = a * hc + bb; }
              __syncthreads(); carry[ch] = hc; __syncthreads(); }
            for (int tt = wave; tt < CH; tt += NWAVES) {
                const size_t row = (size_t)b * SEQ + chunk * CH + tt;
                const v4u hl = *(const GAS v4u*)(HL + row * DLRU + lane * 8), pc = *(const GAS v4u*)(PC + row * DLRU + lane * 8), gt = *(const GAS v4u*)(Z + row * DIN + ZC_G + lane * 8);
                const unsigned hw[4] = {hl.x, hl.y, hl.z, hl.w}, pw[4] = {pc.x, pc.y, pc.z, pc.w}, gv[4] = {gt.x, gt.y, gt.z, gt.w};
                float y[8]; float ss = 0.f;
#pragma unroll
                for (int e = 0; e < 4; ++e) { const float c0 = carry[lane * 8 + 2 * e], c1 = carry[lane * 8 + 2 * e + 1];
                    const float h0 = bflo(hw[e]) + bflo(pw[e]) * c0, h1 = bfhi(hw[e]) + bfhi(pw[e]) * c1;
                    y[2 * e] = h0 * gelu_tanh(bflo(gv[e])); y[2 * e + 1] = h1 * gelu_tanh(bfhi(gv[e])); ss += y[2 * e] * y[2 * e] + y[2 * e + 1] * y[2 * e + 1]; }
                const float rinv = 1.0f / sqrtf(wave_sum(ss) * (1.0f / 512.0f) + EPS);
                const f32x4 g0 = *(const GAS f32x4*)(g_lru_out + lane * 8), g1 = *(const GAS f32x4*)(g_lru_out + lane * 8 + 4);
                v4u o; o.x = pk2(y[0] * rinv * g0.x, y[1] * rinv * g0.y); o.y = pk2(y[2] * rinv * g0.z, y[3] * rinv * g0.w); o.z = pk2(y[4] * rinv * g1.x, y[5] * rinv * g1.y); o.w = pk2(y[6] * rinv * g1.z, y[7] * rinv * g1.w);
                *(GAS v4u*)(A0 + row * D + lane * 8) = o;
                {
                    const int hd = lane >> 3;
                    const float l0 = LSE[((size_t)0 * M + row) * NH + hd], l1 = LSE[((size_t)1 * M + row) * NH + hd], l2 = LSE[((size_t)2 * M + row) * NH + hd];
                    const float mm = fmaxf(l0, fmaxf(l1, l2));
                    float w0 = __expf(l0 - mm), w1 = __expf(l1 - mm), w2 = __expf(l2 - mm); const float iw = 1.0f / (w0 + w1 + w2); w0 *= iw; w1 *= iw; w2 *= iw;
                    const v4u a0 = *(const GAS v4u*)(OB + ((size_t)0 * M + row) * 512 + lane * 8), a1 = *(const GAS v4u*)(OB + ((size_t)1 * M + row) * 512 + lane * 8), a2 = *(const GAS v4u*)(OB + ((size_t)2 * M + row) * 512 + lane * 8);
                    const unsigned u0[4] = {a0.x, a0.y, a0.z, a0.w}, u1[4] = {a1.x, a1.y, a1.z, a1.w}, u2[4] = {a2.x, a2.y, a2.z, a2.w};
                    float ya[8]; float sa = 0.f;
#pragma unroll
                    for (int e = 0; e < 4; ++e) { ya[2 * e] = w0 * bflo(u0[e]) + w1 * bflo(u1[e]) + w2 * bflo(u2[e]); ya[2 * e + 1] = w0 * bfhi(u0[e]) + w1 * bfhi(u1[e]) + w2 * bfhi(u2[e]);
                        sa += ya[2 * e] * ya[2 * e] + ya[2 * e + 1] * ya[2 * e + 1]; }
                    const float ra = 1.0f / sqrtf(wave_sum(sa) * (1.0f / 512.0f) + EPS);
                    const f32x4 ga = *(const GAS f32x4*)(g_attn_out + lane * 8), gb = *(const GAS f32x4*)(g_attn_out + lane * 8 + 4);
                    v4u oa; oa.x = pk2(ya[0] * ra * ga.x, ya[1] * ra * ga.y); oa.y = pk2(ya[2] * ra * ga.z, ya[3] * ra * ga.w); oa.z = pk2(ya[4] * ra * gb.x, ya[5] * ra * gb.y); oa.w = pk2(ya[6] * ra * gb.z, ya[7] * ra * gb.w);
                    *(GAS v4u*)(A0 + row * D + 512 + lane * 8) = oa;
                }
            }
        }
    }
    SEAM(3);

    if (IN(4)) for (int rep_ = 0; rep_ < (REPP == 4 ? 2 : 1); ++rep_) { if (rep_) xcd_barrier(bar);
        pg8::Gemm g{A0, Wout_t, M, D, D}; pg8::StaticOrder S; S.init(M, D, G, bx);
        pg8::EpiResid E{x, out, A1, ssq1};
        pg8::gemm_phase<pg8::EpiResid, pg8::StaticOrder, PG8_ALIGN, PG8_SP2>(lds, g, S, E);
    }
    SEAM(4);

    if (IN(5)) for (int rep_ = 0; rep_ < (REPP == 5 ? 2 : 1); ++rep_) { if (rep_) xcd_barrier(bar);
        pg8::Gemm g{A1, Wcomb_t, M, 2048, D}; pg8::StaticOrder S; S.init(M, 2048, G, bx);
        pg8::EpiScore E{S16, ssq1, EPS};
        pg8::gemm_phase<pg8::EpiScore, pg8::StaticOrder, PG8_ALIGN, PG8_SP2>(lds, g, S, E);
    }
    SEAM(5);

    if (IN(6)) for (int rep_ = 0; rep_ < (REPP == 6 ? 2 : 1); ++rep_) { if (rep_) xcd_barrier(bar);
        for (int item = bx * NT + tid; item < M * NH; item += G * NT) {
            const int tok = item >> 3, h = item & 7;
            const GAS v4u* sp = (const GAS v4u*)(S16 + (size_t)tok * 2048 + h * 256);
            int top1[16], top2[16], bat[16], tk[16];
            v4u ring[8];
#pragma unroll
            for (int s4 = 0; s4 < 4; ++s4) { ring[2 * s4] = sp[(s4 & 1) * 16 + 2 * (s4 >> 1)]; ring[2 * s4 + 1] = sp[(s4 & 1) * 16 + 2 * (s4 >> 1) + 1]; }
#pragma unroll
            for (int st = 0; st < 16; ++st) { const int L = st & 1, bb = st >> 1, sl = (st & 3) * 2;
                const unsigned w[8] = {ring[sl].x, ring[sl].y, ring[sl].z, ring[sl].w, ring[sl + 1].x, ring[sl + 1].y, ring[sl + 1].z, ring[sl + 1].w};
                if (st + 4 < 16) { const int n4 = st + 4; ring[sl] = sp[(n4 & 1) * 16 + 2 * (n4 >> 1)]; ring[sl + 1] = sp[(n4 & 1) * 16 + 2 * (n4 >> 1) + 1]; }
#pragma unroll
                for (int e = 0; e < 8; ++e) { bat[2 * e] = rt_key(w[e] & 0xffffu, bb * 16 + 2 * e); bat[2 * e + 1] = rt_key(w[e] >> 16, bb * 16 + 2 * e + 1); }
                rt_sort16(bat);
                if (L == 0) { if (bb == 0) {
#pragma unroll
                        for (int i = 0; i < 16; ++i) top1[i] = bat[i]; } else rt_merge16(top1, bat); }
                else { if (bb == 0) {
#pragma unroll
                        for (int i = 0; i < 16; ++i) top2[i] = bat[i]; } else rt_merge16(top2, bat); } }
            rt_pairs(top1, top2, tk);
            LAS unsigned* myl = (LAS unsigned*)(lds + tid * 32);
#pragma unroll
            for (int q = 0; q < 4; ++q) { myl[q] = (unsigned)(rt_unkey(top1[4 * q]) & 127) | ((unsigned)(rt_unkey(top1[4 * q + 1]) & 127) << 8) | ((unsigned)(rt_unkey(top1[4 * q + 2]) & 127) << 16) | ((unsigned)(rt_unkey(top1[4 * q + 3]) & 127) << 24);
                myl[4 + q] = (unsigned)(rt_unkey(top2[4 * q]) & 127) | ((unsigned)(rt_unkey(top2[4 * q + 1]) & 127) << 8) | ((unsigned)(rt_unkey(top2[4 * q + 2]) & 127) << 16) | ((unsigned)(rt_unkey(top2[4 * q + 3]) & 127) << 24); }
            int ti[16]; float e[16]; float l = 0.f;
            const float smax = rt_f(rt_unkey(tk[0]) & ~255);
#pragma unroll
            for (int i = 0; i < 16; ++i) { const int u = rt_unkey(tk[i]); const int ab = u & 255;
                const LAS unsigned char* lb = (const LAS unsigned char*)myl;
                ti[i] = (int)lb[ab >> 4] * NKEY + (int)lb[16 + (ab & 15)];
                e[i] = __expf(rt_f(u & ~255) - smax); l += e[i]; }
            const float il = 1.0f / l;
#pragma unroll
            for (int q = 0; q < 8; ++q) { pg8::u32x2 iv; iv.x = (unsigned)ti[q]; iv.y = (unsigned)ti[q + 8]; *(GAS pg8::u32x2*)(ids + (size_t)tok * NSLOT + q * 16 + h * 2) = iv;
                pg8::f32x2 gv; gv.x = e[q] * il; gv.y = e[q + 8] * il; *(GAS pg8::f32x2*)(gwt + (size_t)tok * NSLOT + q * 16 + h * 2) = gv; }
        }
    }
    SEAM(6);

#define PEER_IDS(idr, t) do { const GAS v4u* ipp_ = (const GAS v4u*)(ids + (size_t)(t) * NSLOT + g8 * 16); \
        _Pragma("unroll") for (int q4 = 0; q4 < 4; ++q4) { const v4u w_ = ipp_[q4]; idr[4 * q4] = w_.x; idr[4 * q4 + 1] = w_.y; idr[4 * q4 + 2] = w_.z; idr[4 * q4 + 3] = w_.w; } } while (0)
#define PEER_GATHER(buf, tab, idr) do { _Pragma("unroll") for (int q = 0; q < 16; ++q) buf[q] = *(const GAS v4u*)(tab + ((size_t)j * 16384 + (idr[q] & 0xffffu)) * 128 + c8 * 16); } while (0)
#define ROW_ADD(p, ctrl) p += __int_as_float(__builtin_amdgcn_update_dpp(0, __float_as_int(p), (ctrl), 0xf, 0xf, false))
#define FP8X4(w, f, o) do { const pg8::f32x2 lo_ = __builtin_amdgcn_cvt_pk_f32_fp8((int)(w), false), hi_ = __builtin_amdgcn_cvt_pk_f32_fp8((int)(w), true); f[o] = lo_.x; f[o + 1] = lo_.y; f[o + 2] = hi_.x; f[o + 3] = hi_.y; } while (0)
    if (IN(7)) for (int rep_ = 0; rep_ < (REPP == 7 ? 2 : 1); ++rep_) { if (rep_) xcd_barrier(bar);
        float* SP = (float*)(ws + WS_Z);
        const int home = (int)(xb_xcc_id() & 7u), c8 = lane & 7, g8 = lane >> 3;
#define PEER_XLOAD(xr, t) do { xr[0] = *(const GAS v4u*)(A1 + (size_t)(t) * D + 128 * j + c8 * 16); xr[1] = *(const GAS v4u*)(A1 + (size_t)(t) * D + 128 * j + c8 * 16 + 8); } while (0)
#define PEER_UCONS(buf, xr, t) do { float xf_[16]; { const unsigned xw_[8] = {xr[0].x, xr[0].y, xr[0].z, xr[0].w, xr[1].x, xr[1].y, xr[1].z, xr[1].w}; \
            _Pragma("unroll") for (int e_ = 0; e_ < 8; ++e_) { xf_[2 * e_] = bflo(xw_[e_]); xf_[2 * e_ + 1] = bfhi(xw_[e_]); } } \
        float r0_ = 0.f, r1_ = 0.f; \
        _Pragma("unroll") for (int q = 0; q < 16; ++q) { float f_[16]; FP8X4(buf[q].x, f_, 0); FP8X4(buf[q].y, f_, 4); FP8X4(buf[q].z, f_, 8); FP8X4(buf[q].w, f_, 12); \
            float p_ = 0.f; _Pragma("unroll") for (int e_ = 0; e_ < 16; ++e_) p_ += f_[e_] * xf_[e_]; \
            ROW_ADD(p_, 0xB1); ROW_ADD(p_, 0x4E); ROW_ADD(p_, 0x141); \
            if (q < 8) r0_ = (c8 == q) ? p_ : r0_; else r1_ = (c8 == q - 8) ? p_ : r1_; } \
        float* sp_ = SP + ((size_t)j * M + (t)) * NSLOT + g8 * 16 + c8; sp_[0] = r0_; sp_[8] = r1_; } while (0)
        for (int s = 0; s < 8; ++s) { const int j = (home + s) & 7;
            for (;;) {
                __syncthreads(); if (tid == 0) MISC[16] = __hip_atomic_fetch_add(ctl + CW_QU + rep_ * 1024 + 64 * j, 1u, RLX_AGENT); __syncthreads();
                const int tile = (int)MISC[16]; if (tile >= M / 64) break;
                const int tbase = tile * 64 + wave * 8;
                unsigned idB[16], idN[16]; v4u bA[16], xA[2], xB[2];
                PEER_IDS(idN, tbase); PEER_IDS(idB, tbase + 1);
                PEER_XLOAD(xA, tbase); PEER_GATHER(bA, PU, idN);
                for (int i = 0; i < 8; ++i) { const int t = tbase + i;
                    if (i < 6) PEER_IDS(idN, t + 2);
                    if (i < 7) PEER_XLOAD(xB, t + 1);
                    pg8::f32x2 xf[8]; { const unsigned xw_[8] = {xA[0].x, xA[0].y, xA[0].z, xA[0].w, xA[1].x, xA[1].y, xA[1].z, xA[1].w};
#pragma unroll
                        for (int e = 0; e < 8; ++e) { xf[e].x = bflo(xw_[e]); xf[e].y = bfhi(xw_[e]); } }
                    float r0 = 0.f, r1 = 0.f;
#pragma unroll
                    for (int q = 0; q < 16; ++q) { const unsigned w_[4] = {bA[q].x, bA[q].y, bA[q].z, bA[q].w}; pg8::f32x2 p2 = (pg8::f32x2){0.f, 0.f};
#pragma unroll
                        for (int d = 0; d < 4; ++d) { const pg8::f32x2 lo = __builtin_amdgcn_cvt_pk_f32_fp8((int)w_[d], false), hi = __builtin_amdgcn_cvt_pk_f32_fp8((int)w_[d], true);
                            p2 = __builtin_elementwise_fma(lo, xf[2 * d], p2); p2 = __builtin_elementwise_fma(hi, xf[2 * d + 1], p2); }
                        float p = p2.x + p2.y;
                        if (i < 7) bA[q] = *(const GAS v4u*)(PU + ((size_t)j * 16384 + (idB[q] & 0xffffu)) * 128 + c8 * 16);
                        ROW_ADD(p, 0xB1); ROW_ADD(p, 0x4E); ROW_ADD(p, 0x141);
                        if (q < 8) r0 = (c8 == q) ? p : r0; else r1 = (c8 == q - 8) ? p : r1; }
                    float* sp = SP + ((size_t)j * M + t) * NSLOT + g8 * 16 + c8; sp[0] = r0; sp[8] = r1;
#pragma unroll
                    for (int q = 0; q < 16; ++q) { idB[q] = idN[q]; }
                    xA[0] = xB[0]; xA[1] = xB[1];
                }
            }
        }
    }
    SEAM(7);

    if (IN(8)) {
        {
            const float* SP = (const float*)(ws + WS_Z);
            for (size_t idx = (size_t)bx * NT + tid; idx < (size_t)M * NSLOT; idx += (size_t)G * NT) { const size_t t = idx >> 7; float sum = 0.f;
#pragma unroll
                for (int jj = 0; jj < 8; ++jj) sum += SP[(size_t)jj * M * NSLOT + idx];
                const float rinv1 = 1.0f / sqrtf(pg8::ssq16(ssq1 + t * 16) * (1.0f / 1024.0f) + EPS);
                const unsigned id = (unsigned)ids[idx] & 0xffffu;
                ids[idx] = (int)((f2bf(gelu_tanh(sum * rinv1 * pscl[id]) * gwt[idx] * pscl[16384 + id]) << 16) | id); }
        }
    }
    SEAM(8);

    if (IN(9)) {
        const int home = (int)(xb_xcc_id() & 7u), c8 = lane & 7, g8 = lane >> 3;
#define PEER_VCONS(buf, idr) do { _Pragma("unroll") for (int q = 0; q < 16; ++q) { const float a_ = __uint_as_float(idr[q] & 0xffff0000u); const unsigned w_[4] = {buf[q].x, buf[q].y, buf[q].z, buf[q].w}; \
            _Pragma("unroll") for (int d_ = 0; d_ < 4; ++d_) { const pg8::f32x2 lo_ = __builtin_amdgcn_cvt_pk_f32_fp8((int)w_[d_], false), hi_ = __builtin_amdgcn_cvt_pk_f32_fp8((int)w_[d_], true); \
                acc[4 * d_] += a_ * lo_.x; acc[4 * d_ + 1] += a_ * lo_.y; acc[4 * d_ + 2] += a_ * hi_.x; acc[4 * d_ + 3] += a_ * hi_.y; } \
            if ((q & 3) == 3) __builtin_amdgcn_sched_barrier(0); } } while (0)
#define PEER_VFIN(t) do { asm volatile("" ::: "memory"); \
        _Pragma("unroll") for (int e_ = 0; e_ < 16; ++e_) { ROW_ADD(acc[e_], 0x128); acc[e_] += __shfl_xor(acc[e_], 16); acc[e_] += __shfl_xor(acc[e_], 32); } \
        float ss_ = 0.f; \
        if (g8 == 0) { const GAS v4u* hp_ = (const GAS v4u*)(A1 + (size_t)(t) * D + 128 * j + c8 * 16); const v4u ha_ = hp_[0], hb_ = hp_[1]; \
            const unsigned hw_[8] = {ha_.x, ha_.y, ha_.z, ha_.w, hb_.x, hb_.y, hb_.z, hb_.w}; unsigned ow_[8]; \
            _Pragma("unroll") for (int e_ = 0; e_ < 8; ++e_) { const float h0_ = bflo(hw_[e_]) + acc[2 * e_], h1_ = bfhi(hw_[e_]) + acc[2 * e_ + 1]; ss_ += h0_ * h0_ + h1_ * h1_; ow_[e_] = pk2(h0_, h1_); } \
            v4u o0_, o1_; o0_.x = ow_[0]; o0_.y = ow_[1]; o0_.z = ow_[2]; o0_.w = ow_[3]; o1_.x = ow_[4]; o1_.y = ow_[5]; o1_.z = ow_[6]; o1_.w = ow_[7]; \
            *(GAS v4u*)(A0 + (size_t)(t) * D + 128 * j + c8 * 16) = o0_; *(GAS v4u*)(A0 + (size_t)(t) * D + 128 * j + c8 * 16 + 8) = o1_; } \
        ss_ += __shfl_xor(ss_, 1); ss_ += __shfl_xor(ss_, 2); ss_ += __shfl_xor(ss_, 4); \
        if (lane == 0) ssq2[(size_t)(t) * 8 + j] = ss_; asm volatile("" ::: "memory"); } while (0)
        for (int s = 0; s < 8; ++s) { const int j = (home + s) & 7;
            for (;;) {
                __syncthreads(); if (tid == 0) MISC[16] = __hip_atomic_fetch_add(ctl + CW_QV + 64 * j, 1u, RLX_AGENT); __syncthreads();
                const int tile = (int)MISC[16]; if (tile >= M / 64) break;
                const int tbase = tile * 64 + wave * 8;
                unsigned idA[16], idB[16], idN[16]; v4u bA[16]; pg8::f32x2 acc2[8];
                PEER_IDS(idA, tbase); PEER_IDS(idB, tbase + 1);
                PEER_GATHER(bA, PV, idA);
                for (int i = 0; i < 8; ++i) { const int t = tbase + i;
                    if (i < 6) PEER_IDS(idN, t + 2);
#pragma unroll
                    for (int e = 0; e < 8; ++e) acc2[e] = (pg8::f32x2){0.f, 0.f};
#pragma unroll
                    for (int q = 0; q < 16; ++q) { const float a_ = __uint_as_float(idA[q] & 0xffff0000u); const pg8::f32x2 a2 = (pg8::f32x2){a_, a_}; const unsigned w_[4] = {bA[q].x, bA[q].y, bA[q].z, bA[q].w};
#pragma unroll
                        for (int d = 0; d < 4; ++d) { const pg8::f32x2 lo = __builtin_amdgcn_cvt_pk_f32_fp8((int)w_[d], false), hi = __builtin_amdgcn_cvt_pk_f32_fp8((int)w_[d], true);
                            acc2[2 * d] = __builtin_elementwise_fma(a2, lo, acc2[2 * d]); acc2[2 * d + 1] = __builtin_elementwise_fma(a2, hi, acc2[2 * d + 1]); }
                        if (i < 7) bA[q] = *(const GAS v4u*)(PV + ((size_t)j * 16384 + (idB[q] & 0xffffu)) * 128 + c8 * 16); }
                    float acc[16];
#pragma unroll
                    for (int e = 0; e < 8; ++e) { acc[2 * e] = acc2[e].x; acc[2 * e + 1] = acc2[e].y; }
                    PEER_VFIN(t);
#pragma unroll
                    for (int q = 0; q < 16; ++q) { idA[q] = idB[q]; idB[q] = idN[q]; }
                }
            }
        }
    }
    SEAM(9);


    if (IN(10)) {
        pg8::Gemm g{A0, Wgate_t, M, D, D}; pg8::StaticOrder S; S.init(M, D, G, bx);
        pg8::EpiPle E{out, A0, Pout, ssq2, ssq3, EPS};
        pg8::gemm_phase<pg8::EpiPle, pg8::StaticOrder, PG8_ALIGN, PG8_SP2>(lds, g, S, E);
    }
    SEAM(10);

    if (IN(11)) {
        for (int m = gw; m < M; m += NGW) {
            const float rinv = 1.0f / sqrtf(pg8::ssq16(ssq3 + (size_t)m * 16) * (1.0f / 1024.0f) + EPS);
            GAS f32x4* op = (GAS f32x4*)(out + (size_t)m * D) + lane;
#pragma unroll
            for (int j = 0; j < 4; ++j) { f32x4 v = op[64 * j]; const f32x4 g = *((const GAS f32x4*)g_final + lane + 64 * j);
                v.x *= rinv * g.x; v.y *= rinv * g.y; v.z *= rinv * g.z; v.w *= rinv * g.w; op[64 * j] = v; }
        }
    }
#undef IN
#undef SEAM
}

extern "C" void kernel_launch(void* const* d_in, const int* in_sizes, int n_in, void* d_out, int out_size, void* d_ws, size_t ws_size, hipStream_t stream) {
    static int grid = 0;
    if (grid == 0) {
        if (n_in != 25 || in_sizes[0] != M * D || out_size != M * D || ws_size < WS_END) { fprintf(stderr, "kernel_launch: unexpected shapes (n_in %d, in0 %d, out %d, ws %zu); nothing launched\n", n_in, n_in > 0 ? in_sizes[0] : -1, out_size, ws_size); grid = -1; return; }
        int dev = 0, cus = 0, per_cu = 0;
        if (hipGetDevice(&dev) != hipSuccess || hipDeviceGetAttribute(&cus, hipDeviceAttributeMultiprocessorCount, dev) != hipSuccess) { grid = -1; return; }
        if (hipFuncSetAttribute((const void*)hybrid_fwd, hipFuncAttributeMaxDynamicSharedMemorySize, LDS_BYTES) != hipSuccess) { fprintf(stderr, "kernel_launch: hipFuncSetAttribute failed\n"); grid = -1; return; }
        if (hipOccupancyMaxActiveBlocksPerMultiprocessor(&per_cu, (const void*)hybrid_fwd, NT, LDS_BYTES) != hipSuccess || per_cu < 1)
            fprintf(stderr, "kernel_launch: note: occupancy query reports %d workgroups per CU\n", per_cu);
        (void)hipGetLastError();
        grid = cus;
    }
    if (grid < 0) return;
    if (hipMemsetAsync((char*)d_ws + WS_CTL, 0, CTL_ZERO_BYTES, stream) != hipSuccess) return;
    Args a{};
    for (int i = 0; i < 25; ++i) a.in[i] = (const float*)d_in[i];
    a.out = (float*)d_out; a.ws = (unsigned char*)d_ws;
    if (N_LAUNCHES == 1) { a.ph_lo = 0; a.ph_hi = NPHASE; hipLaunchKernelGGL(hybrid_fwd, dim3(grid), dim3(NT), LDS_BYTES, stream, a); }
    else for (int li = 0; li < NPHASE; ++li) { a.ph_lo = li; a.ph_hi = li + 1; hipLaunchKernelGGL(hybrid_fwd, dim3(grid), dim3(NT), LDS_BYTES, stream, a); }
}
```
